# Optimizing an MI355X kernel written in HIP

```python
import jax, jax.numpy as jnp
from jax import lax
import numpy as np

D_MODEL = 1024
BATCH = 8
SEQ = 2048
DEPTH = 2
DEC_BATCH = 128
DEC_SEQ = 1
PAST_LEN = 16384
PAGE_SIZE = 128

D_MIX = D_MODEL
W_A = D_MIX // 2
W_B = D_MIX - W_A
POOL_WINDOWS = (2, 4, 8, 16)
N_POOL_GROUPS = len(POOL_WINDOWS)
POOL_GROUP_DIM = W_A // N_POOL_GROUPS
POOL_BUF = max(POOL_WINDOWS) - 1
CHUNK = 128
N_HEADS_B = 4
HEAD_DIM_B = W_B // N_HEADS_B
D_IN = 2 * W_A + 3 * W_B
EPS = 1e-6

kernel_name = "hymba_pool_chunkmlp_step"


def rmsnorm(x, g):
    xf = x.astype(jnp.float32)
    y = xf * lax.rsqrt(jnp.mean(xf * xf, axis=-1, keepdims=True) + EPS)
    return (y * g.astype(jnp.float32)).astype(x.dtype)


def pool_mix(ctx, n_past, start_pos, w_pool, scale):
    B, L, W = ctx.shape
    T = L - n_past
    cf = ctx.astype(jnp.float32)
    cs = jnp.concatenate([jnp.zeros((B, 1, W), jnp.float32), jnp.cumsum(cf, axis=1)], axis=1)
    idx = np.arange(T) + n_past
    pos = start_pos + np.arange(T)
    means = []
    for g, w in enumerate(POOL_WINDOWS):
        sl = slice(g * POOL_GROUP_DIM, (g + 1) * POOL_GROUP_DIM)
        hi = cs[:, idx + 1, sl]
        lo = cs[:, np.maximum(idx + 1 - w, 0), sl]
        cnt = jnp.asarray(np.minimum(pos + 1, w), jnp.float32)[None, :, None]
        means.append((hi - lo) / cnt)
    d = (jnp.concatenate(means, axis=-1) - cf[:, n_past:]).astype(ctx.dtype)
    d = d.reshape(B, T, N_POOL_GROUPS, POOL_GROUP_DIM)
    y = jnp.einsum('btgc,gcd->btgd', d, w_pool).reshape(B, T, W_A)
    return y * scale


def chunk_mix(u, v, w_s, b_s):
    B, T, H, Dh = v.shape
    L = min(T, CHUNK)
    nc = -(-T // L)
    Tp = nc * L
    mask = np.tril(np.ones((L, L), dtype=bool))
    ws = jnp.where(mask[None], w_s[:, :L, :L], 0)
    vp = jnp.pad(v, ((0, 0), (0, Tp - T), (0, 0), (0, 0))).reshape(B, nc, L, H, Dh)
    s = jnp.einsum('hij,bcjhd->bcihd', ws, vp) + jnp.transpose(b_s[:, :L])[None, None, :, :, None]
    s = s.reshape(B, Tp, H, Dh)[:, :T]
    return u * s


def layer(x, past_pool, start_pos, norm_g, w_in, w_pool, pool_scale, v_norm_g, w_s, b_s, w_out):
    B, T, _ = x.shape
    h = rmsnorm(x, norm_g)
    proj = jnp.einsum('btd,de->bte', h, w_in)
    a_in = proj[..., :W_A]
    a_gate = proj[..., W_A:2 * W_A]
    u = proj[..., 2 * W_A:2 * W_A + W_B]
    v = proj[..., 2 * W_A + W_B:2 * W_A + 2 * W_B]
    b_gate = proj[..., 2 * W_A + 2 * W_B:]
    ctx = jnp.concatenate([past_pool.astype(a_in.dtype), a_in], axis=1)
    a_out = pool_mix(ctx, past_pool.shape[1], start_pos, w_pool, pool_scale) * jax.nn.silu(a_gate)
    vn = rmsnorm(v.reshape(B, T, N_HEADS_B, HEAD_DIM_B), v_norm_g.reshape(N_HEADS_B, HEAD_DIM_B))
    b_out = chunk_mix(u.reshape(B, T, N_HEADS_B, HEAD_DIM_B), vn, w_s, b_s).reshape(B, T, W_B)
    b_out = b_out * jax.nn.silu(b_gate)
    y = x + jnp.einsum('bte,ed->btd', jnp.concatenate([a_out, b_out], axis=-1), w_out)
    new_pool = ctx[:, -POOL_BUF:]
    n_last = (T - 1) % CHUNK + 1
    new_v = vn.reshape(B, T, W_B)[:, T - n_last:]
    return y, new_pool, new_v


def setup_inputs(seed: int = 0) -> dict:
    key = jax.random.key(seed)
    ks = jax.random.split(key, 12)
    nrm = jax.random.normal
    return {
        "x_prompt": nrm(ks[0], (BATCH, SEQ, D_MODEL), jnp.float32),
        "x_sample": nrm(ks[1], (DEC_BATCH, DEC_SEQ, D_MODEL), jnp.float32),
        "state_pool": nrm(ks[2], (DEPTH, DEC_BATCH, POOL_BUF, W_A), jnp.float32),
        "norm_g": 1.0 + 0.1 * nrm(ks[3], (DEPTH, D_MODEL), jnp.float32),
        "w_in": nrm(ks[4], (DEPTH, D_MODEL, D_IN), jnp.float32) * D_MODEL ** -0.5,
        "w_pool": nrm(ks[5], (DEPTH, N_POOL_GROUPS, POOL_GROUP_DIM, POOL_GROUP_DIM), jnp.float32) * POOL_GROUP_DIM ** -0.5,
        "pool_scale": 1.0 + 0.1 * nrm(ks[6], (DEPTH, W_A), jnp.float32),
        "v_norm_g": 1.0 + 0.1 * nrm(ks[7], (DEPTH, W_B), jnp.float32),
        "w_s": nrm(ks[8], (DEPTH, N_HEADS_B, CHUNK, CHUNK), jnp.float32) * CHUNK ** -0.5,
        "b_s": 1.0 + 0.1 * nrm(ks[9], (DEPTH, N_HEADS_B, CHUNK), jnp.float32),
        "w_out": nrm(ks[10], (DEPTH, D_MIX, D_MODEL), jnp.float32) * D_MIX ** -0.5,
        "final_norm_g": 1.0 + 0.1 * nrm(ks[11], (D_MODEL,), jnp.float32),
    }


def reference(x_prompt, x_sample, state_pool, norm_g, w_in, w_pool, pool_scale, v_norm_g, w_s, b_s, w_out, final_norm_g):
    yp, ys = x_prompt, x_sample
    empty_past = jnp.zeros((x_prompt.shape[0], 0, W_A), x_prompt.dtype)
    pool_p, pool_s, cv_p, cv_s = [], [], [], []
    for l in range(DEPTH):
        params = (norm_g[l], w_in[l], w_pool[l], pool_scale[l], v_norm_g[l], w_s[l], b_s[l], w_out[l])
        yp, npp, nvp = layer(yp, empty_past, 0, *params)
        ys, nps, nvs = layer(ys, state_pool[l], PAST_LEN, *params)
        pool_p.append(npp); pool_s.append(nps); cv_p.append(nvp); cv_s.append(nvs)
    y_prompt = rmsnorm(yp, final_norm_g)
    y_sample = rmsnorm(ys, final_norm_g)
    pool_prompt = jnp.stack(pool_p, axis=0)
    pool_sample = jnp.stack(pool_s, axis=0)
    chunk_v_prompt = jnp.stack(cv_p, axis=0)
    chunk_v_sample = jnp.stack(cv_s, axis=0)
    return (y_prompt, y_sample, pool_prompt, pool_sample, chunk_v_prompt, chunk_v_sample)
```

```cpp
#include <hip/hip_runtime.h>
#include <hip/hip_cooperative_groups.h>
#include <cstdio>
#include <cstdint>
namespace cg = cooperative_groups;
namespace pg8 {
#define PG8_LAS __attribute__((address_space(3)))
typedef unsigned short bf16_t;
typedef short bf16x8 __attribute__((ext_vector_type(8)));
typedef float f32x4 __attribute__((ext_vector_type(4)));
typedef unsigned u32x4 __attribute__((ext_vector_type(4)));
constexpr int BM = 256, BK = 64, HALF = 128, HTB = HALF * BK * 2  , STAGE_BYTES = 8 * HTB, NXCD = 8, WGM = 8;

__host__ __device__ __forceinline__ int lds_byte(int r, int c) { const int st = (r >> 4) * 2 + (c >> 5), rr = r & 15, cc = c & 31, ob = rr * 64 + cc * 2; return st * 1024 + (ob ^ (((ob >> 9) & 1) << 5)); }
__host__ __device__ __forceinline__ void stage_rc(int b, int& R, int& C) { const int st = b / 1024, sb = b % 1024, swz = sb ^ (((sb >> 9) & 1) << 5); R = (st >> 1) * 16 + swz / 64; C = (st & 1) * 32 + (swz % 64) / 2; }
__host__ __device__ __forceinline__ int perm32(int rho) { const int n = rho >> 4, i = rho & 15; return 8 * (i >> 2) + 4 * n + (i & 3); }

struct Unit { int pm, pn; };
struct Gemm { const bf16_t* A; const bf16_t* Bt; int M, N, K; };

struct StaticOrder {
    int nM, nN, nwg, G, c;
    __host__ __device__ void init(int M, int N, int G_, int c_) { nM = M / BM; nN = N / BM; nwg = nM * nN; G = G_; c = c_; }
    __host__ __device__ bool next(int i, Unit& u) const {
        const long L = (long)i * G + c; if (L >= nwg) return false;
        int wgid = (int)L; { const int q = nwg / NXCD, r = nwg % NXCD, xcd = wgid % NXCD, off = wgid / NXCD; wgid = (xcd < r ? xcd * (q + 1) : r * (q + 1) + (xcd - r) * q) + off; }
        const int nig = WGM * nN, gid = wgid / nig, fm = gid * WGM, gsz = (nM - fm) < WGM ? (nM - fm) : WGM;
        u.pm = fm + ((wgid % nig) % gsz); u.pn = (wgid % nig) / gsz; return true;
    }
    __device__ __forceinline__ void a_ready(const Unit&) const {}
    __device__ __forceinline__ void done(const Unit&) const {}
};

__device__ __forceinline__ unsigned cvt_pk_bf16(float lo, float hi) { unsigned r; asm volatile("v_cvt_pk_bf16_f32 %0, %1, %2" : "=v"(r) : "v"(lo), "v"(hi)); return r; }
typedef unsigned u32x2 __attribute__((ext_vector_type(2)));
struct EpiProj {
    static constexpr bool PERM = true, AFTER_DRAIN = false;
    bf16_t* O; int ldc; const PG8_LAS float* rs; int pm0, pm1;
    __device__ __forceinline__ void operator()(const f32x4 (&acc)[2][2][4][2], const Unit& u, int wr, int wc, int fr, int fq) const {
        const int row0 = u.pm * BM + wr * 64 + fr, col0 = u.pn * BM + wc * 32 + 8 * fq;
        const PG8_LAS float* rp = rs + (u.pm == pm0 ? 0 : (u.pm == pm1 ? 256 : 512)) + wr * 64 + fr;
#pragma unroll
        for (int ai = 0; ai < 2; ++ai)
#pragma unroll
            for (int m = 0; m < 4; ++m) { const int row = row0 + ai * HALF + m * 16; const float rsv = rp[ai * HALF + m * 16];
                bf16_t* rowp = O + (size_t)row * ldc + col0;
#pragma unroll
                for (int bj = 0; bj < 2; ++bj) { const f32x4 v0 = acc[ai][bj][m][0] * rsv, v1 = acc[ai][bj][m][1] * rsv;
                    u32x4 w; w.x = cvt_pk_bf16(v0[0], v0[1]); w.y = cvt_pk_bf16(v0[2], v0[3]); w.z = cvt_pk_bf16(v1[0], v1[1]); w.w = cvt_pk_bf16(v1[2], v1[3]);
                    *(u32x4*)(rowp + bj * HALF) = w; } }
    }
};
struct EpiOut {
    static constexpr bool PERM = false, AFTER_DRAIN = false;
    const float* base; float* out; bf16_t* xn; float* ssq; int ldc; int last;
    __device__ __forceinline__ void operator()(const f32x4 (&acc)[2][2][4][2], const Unit& u, int wr, int wc, int fr, int fq) const {
        const int col0 = u.pn * BM + wc * 32 + 4 * fq;
#pragma unroll
        for (int ai = 0; ai < 2; ++ai)
#pragma unroll
            for (int m = 0; m < 4; ++m) { const int row = u.pm * BM + ai * HALF + wr * 64 + m * 16 + fr; const size_t off = (size_t)row * ldc + col0; float q = 0.f;
#pragma unroll
                for (int bj = 0; bj < 2; ++bj)
#pragma unroll
                    for (int n = 0; n < 2; ++n) { const f32x4 bs = *(const f32x4*)(base + off + bj * HALF + n * 16); const f32x4 o = bs + acc[ai][bj][m][n];
                        *(f32x4*)(out + off + bj * HALF + n * 16) = o;
                        if (!last) { q += (o[0] * o[0] + o[1] * o[1]) + (o[2] * o[2] + o[3] * o[3]); u32x2 w; w.x = cvt_pk_bf16(o[0], o[1]); w.y = cvt_pk_bf16(o[2], o[3]); *(u32x2*)(xn + off + bj * HALF + n * 16) = w; } }
                if (!last) { q += __shfl_xor(q, 16); q += __shfl_xor(q, 32); if (fq == 0) ssq[(size_t)row * 16 + u.pn * 4 + wc] = q; }
                if (m & 1) asm volatile("" ::: "memory"); }
    }
};
template <class Epi, class Sched, bool ALIGN_EPI = false, bool SP2 = false>
__device__ __forceinline__ void gemm_phase(PG8_LAS unsigned char* lds, const Gemm g, const Sched& S, const Epi& E) {
    int tid_l = threadIdx.x; asm volatile("" : "+v"(tid_l));
    const int tid = tid_l, wid = __builtin_amdgcn_readfirstlane(tid >> 6), lane = tid & 63, wr = wid >> 2, wc = wid & 3, fr = lane & 15, fq = lane >> 4;
    const int K = g.K, nt = K / BK;
    unsigned voffA[2], voffB[2];
#pragma unroll
    for (int i = 0; i < 2; ++i) { int R, C; stage_rc(tid * 16 + i * 8192, R, C); const int Rb = Epi::PERM ? ((R & ~31) + perm32(R & 31)) : R;
        voffA[i] = (unsigned)(R * K + C) * 2u; voffB[i] = (unsigned)(Rb * K + C) * 2u; }
    const size_t kstep = (size_t)(BK * 2);
    const size_t hstep = (size_t)HALF * K * 2;
    const size_t tstep = 2 * hstep;
    const unsigned ldsw = (unsigned)wid * 1024u;
    const int aoff = lds_byte(wr * 64 + fr, fq * 8), boff = lds_byte(wc * 32 + fr, fq * 8);
#define PG8_SA(b, h) (((b) * 2 + (h)) * HTB)
#define PG8_SB(b, h) ((4 + (b) * 2 + (h)) * HTB)
#define PG8_STAGE(bufoff, gbase, voff) do { _Pragma("unroll") for (int _i = 0; _i < 2; ++_i) \
        __builtin_amdgcn_global_load_lds((const unsigned*)((const char*)(gbase) + (voff)[_i]), (PG8_LAS unsigned*)(lds + (bufoff) + ldsw + _i * 8192), 16, 0, 0); } while (0)
#define PG8_LDA(dst, b, h) do { _Pragma("unroll") for (int m = 0; m < 4; ++m) _Pragma("unroll") for (int k = 0; k < 2; ++k) dst[m][k] = *(const PG8_LAS bf16x8*)(lds + PG8_SA(b, h) + aoff + m * 2048 + k * 1024); } while (0)
#define PG8_LDB(dst, b, h) do { _Pragma("unroll") for (int n = 0; n < 2; ++n) _Pragma("unroll") for (int k = 0; k < 2; ++k) dst[n][k] = *(const PG8_LAS bf16x8*)(lds + PG8_SB(b, h) + boff + n * 2048 + k * 1024); } while (0)
#define PG8_MMA(ai, bj, At, Bt) do { __builtin_amdgcn_s_setprio(1); _Pragma("unroll") for (int m = 0; m < 4; ++m) _Pragma("unroll") for (int n = 0; n < 2; ++n) _Pragma("unroll") for (int k = 0; k < 2; ++k) \
        acc[ai][bj][m][n] = __builtin_amdgcn_mfma_f32_16x16x32_bf16(Bt[n][k], At[m][k], acc[ai][bj][m][n], 0, 0, 0); __builtin_amdgcn_s_setprio(0); } while (0)
#define PG8_WAIT_V(n) asm volatile("s_waitcnt vmcnt(" #n ")" ::: "memory")
#define PG8_WAIT_L(n) asm volatile("s_waitcnt lgkmcnt(" #n ")" ::: "memory")
#define PG8_BAR __builtin_amdgcn_s_barrier()
#define PG8_SCHED __builtin_amdgcn_sched_barrier(0)
    Unit cur, nxt; int ui = 0;
    if (!S.next(0, cur)) return;
    f32x4 acc[2][2][4][2];
#pragma unroll
    for (int a = 0; a < 2; ++a)
#pragma unroll
        for (int b = 0; b < 2; ++b)
#pragma unroll
            for (int m = 0; m < 4; ++m)
#pragma unroll
                for (int n = 0; n < 2; ++n) acc[a][b][m][n] = (f32x4){0.f, 0.f, 0.f, 0.f};
    bf16x8 At[4][2], B0[2][2], B1[2][2];
    const char* cA = (const char*)g.A + (size_t)cur.pm * tstep; const char* cB = (const char*)g.Bt + (size_t)cur.pn * tstep;
    S.a_ready(cur);
    if constexpr (SP2) {
        PG8_STAGE(PG8_SB(0, 0), cB, voffB); PG8_STAGE(PG8_SB(0, 1), cB + hstep, voffB); PG8_STAGE(PG8_SA(0, 0), cA, voffA); PG8_STAGE(PG8_SA(0, 1), cA + hstep, voffA);
        if (wr == 1) PG8_BAR;
        PG8_WAIT_V(2); PG8_BAR;
        PG8_STAGE(PG8_SB(1, 0), cB + kstep, voffB); PG8_STAGE(PG8_SA(1, 0), cA + kstep, voffA); PG8_STAGE(PG8_SB(1, 1), cB + hstep + kstep, voffB);
        PG8_WAIT_V(6); PG8_BAR;
    } else {
        PG8_STAGE(PG8_SB(0, 0), cB, voffB); PG8_STAGE(PG8_SA(0, 0), cA, voffA); PG8_STAGE(PG8_SB(0, 1), cB + hstep, voffB); PG8_STAGE(PG8_SA(0, 1), cA + hstep, voffA);
        if (wr == 1) PG8_BAR;
        PG8_WAIT_V(4); PG8_BAR;
        PG8_STAGE(PG8_SB(1, 0), cB + kstep, voffB); PG8_STAGE(PG8_SA(1, 0), cA + kstep, voffA); PG8_STAGE(PG8_SB(1, 1), cB + hstep + kstep, voffB);
        PG8_WAIT_V(6); PG8_BAR;
    }
    for (;;) {
        const bool has_next = S.next(ui + 1, nxt);
        const char* nA = has_next ? (const char*)g.A + (size_t)nxt.pm * tstep : cA; const char* nB = has_next ? (const char*)g.Bt + (size_t)nxt.pn * tstep : cB;
        for (int t = 0; t < nt; t += 2) {
            const bool last = (t == nt - 2);
            const char* a1 = cA + (size_t)(t + 1) * kstep;
            const char* a2 = last ? nA : cA + (size_t)(t + 2) * kstep; const char* b2 = last ? nB : cB + (size_t)(t + 2) * kstep;
            const char* a3 = a2 + kstep; const char* b3 = b2 + kstep;
            if (last && has_next) S.a_ready(nxt);
            if constexpr (SP2) {
            PG8_LDB(B0, 0, 0); PG8_LDB(B1, 0, 1); PG8_SCHED; PG8_LDA(At, 0, 0); PG8_STAGE(PG8_SA(1, 1), a1 + hstep, voffA);
            PG8_WAIT_V(8); PG8_WAIT_L(0); PG8_BAR; PG8_MMA(0, 0, At, B0); PG8_MMA(0, 1, At, B1); PG8_BAR; PG8_SCHED;
            PG8_LDA(At, 0, 1); PG8_STAGE(PG8_SB(0, 0), b2, voffB); PG8_STAGE(PG8_SB(0, 1), b2 + hstep, voffB); PG8_STAGE(PG8_SA(0, 0), a2, voffA);
            PG8_WAIT_V(8); PG8_WAIT_L(0); PG8_BAR; PG8_MMA(1, 0, At, B0); PG8_MMA(1, 1, At, B1); PG8_BAR; PG8_SCHED;
            PG8_LDB(B0, 1, 0); PG8_LDB(B1, 1, 1); PG8_SCHED; PG8_LDA(At, 1, 0); PG8_STAGE(PG8_SA(0, 1), a2 + hstep, voffA);
            PG8_WAIT_V(8); PG8_WAIT_L(0); PG8_BAR; PG8_MMA(0, 0, At, B0); PG8_MMA(0, 1, At, B1); PG8_BAR; PG8_SCHED;
            PG8_LDA(At, 1, 1); PG8_STAGE(PG8_SB(1, 0), b3, voffB); PG8_STAGE(PG8_SB(1, 1), b3 + hstep, voffB); PG8_STAGE(PG8_SA(1, 0), a3, voffA);
            PG8_WAIT_V(8); PG8_WAIT_L(0); PG8_BAR; PG8_MMA(1, 0, At, B0); PG8_MMA(1, 1, At, B1); PG8_BAR; PG8_SCHED;
            } else {
            PG8_LDB(B0, 0, 0); PG8_SCHED; PG8_LDA(At, 0, 0); PG8_STAGE(PG8_SA(1, 1), a1 + hstep, voffA);
            PG8_WAIT_L(8); PG8_BAR; PG8_WAIT_L(0); PG8_MMA(0, 0, At, B0); PG8_BAR; PG8_SCHED;
            PG8_LDB(B1, 0, 1); PG8_STAGE(PG8_SB(0, 0), b2, voffB);
            PG8_BAR; PG8_WAIT_L(0); PG8_MMA(0, 1, At, B1); PG8_BAR;
            PG8_LDA(At, 0, 1); PG8_STAGE(PG8_SA(0, 0), a2, voffA);
            PG8_BAR; PG8_WAIT_L(0); PG8_MMA(1, 0, At, B0); PG8_BAR; PG8_SCHED;
            PG8_STAGE(PG8_SB(0, 1), b2 + hstep, voffB);
            PG8_WAIT_V(6); PG8_BAR; PG8_MMA(1, 1, At, B1); PG8_BAR;
            PG8_LDB(B0, 1, 0); PG8_SCHED; PG8_LDA(At, 1, 0); PG8_STAGE(PG8_SA(0, 1), a2 + hstep, voffA);
            PG8_WAIT_L(8); PG8_BAR; PG8_WAIT_L(0); PG8_MMA(0, 0, At, B0); PG8_BAR; PG8_SCHED;
            PG8_LDB(B1, 1, 1); PG8_STAGE(PG8_SB(1, 0), b3, voffB);
            PG8_BAR; PG8_WAIT_L(0); PG8_MMA(0, 1, At, B1); PG8_BAR;
            PG8_LDA(At, 1, 1); PG8_STAGE(PG8_SA(1, 0), a3, voffA);
            PG8_BAR; PG8_WAIT_L(0); PG8_MMA(1, 0, At, B0); PG8_BAR; PG8_SCHED;
            PG8_STAGE(PG8_SB(1, 1), b3 + hstep, voffB);
            PG8_WAIT_V(6); PG8_BAR; PG8_MMA(1, 1, At, B1); PG8_BAR;
            }
        }
        if constexpr (ALIGN_EPI) { if (wr == 0) PG8_BAR; }
        if constexpr (!Epi::AFTER_DRAIN) { E(acc, cur, wr, wc, fr, fq); S.done(cur); }
        if (!has_next) break;
#pragma unroll
        for (int a = 0; a < 2; ++a)
#pragma unroll
            for (int b = 0; b < 2; ++b)
#pragma unroll
                for (int m = 0; m < 4; ++m)
#pragma unroll
                    for (int n = 0; n < 2; ++n) acc[a][b][m][n] = (f32x4){0.f, 0.f, 0.f, 0.f};
        cur = nxt; cA = nA; cB = nB; ++ui;
        if constexpr (ALIGN_EPI) { if (wr == 1) PG8_BAR; }
    }
    PG8_WAIT_V(0);
    if constexpr (!ALIGN_EPI) { if (wr == 0) PG8_BAR; }
    PG8_BAR;
    if constexpr (Epi::AFTER_DRAIN) { E.fused(acc, cur, wr, wc, fr, fq, lds, wid, lane); S.done(cur); }
#undef PG8_SA
#undef PG8_SB
#undef PG8_STAGE
#undef PG8_LDA
#undef PG8_LDB
#undef PG8_MMA
#undef PG8_WAIT_V
#undef PG8_WAIT_L
#undef PG8_BAR
#undef PG8_SCHED
}
}

constexpr int D_MODEL = 1024, BATCH = 8, SEQ = 2048, DEPTH = 2, DEC_BATCH = 128, W_A = 512, W_B = 512, NGRP = 4, GD = 128, POOL_BUF = 15, CHUNK = 128, NHB = 4, HDB = 128, D_IN = 2560;
constexpr int MP = BATCH * SEQ;
constexpr int MV = MP + DEC_BATCH;
constexpr int MT = MP + 256;
constexpr int NCHUNK = MP / CHUNK;
constexpr float EPS = 1e-6f;
constexpr size_t O_YP = 0, O_YS = (size_t)MP * D_MODEL, O_PP = O_YS + (size_t)DEC_BATCH * D_MODEL, O_PS = O_PP + (size_t)DEPTH * BATCH * POOL_BUF * W_A,
                 O_CVP = O_PS + (size_t)DEPTH * DEC_BATCH * POOL_BUF * W_A, O_CVS = O_CVP + (size_t)DEPTH * BATCH * CHUNK * W_B;
constexpr size_t MiB = 1u << 20;
constexpr size_t WS_WIN = 1 * MiB, WS_WOUT = 11 * MiB, WS_WP = 15 * MiB, WS_WSB = 15 * MiB + 512 * 1024, WS_SSQ = 16 * MiB, WS_XN = 18 * MiB, WS_MIX = 51 * MiB, WS_PROJ = 84 * MiB, WS_Y1 = 166 * MiB, WS_END = 231 * MiB;
static_assert(WS_XN + (size_t)MT * D_MODEL * 2 <= WS_MIX && WS_MIX + (size_t)MT * D_MODEL * 2 <= WS_PROJ && WS_PROJ + (size_t)MT * D_IN * 2 <= WS_Y1 && WS_Y1 + (size_t)MT * D_MODEL * 4 <= WS_END && WS_SSQ + (size_t)MT * 64 <= WS_XN, "ws map");
constexpr int TS = 272;
constexpr int R_A = 0, R_B = 144 * TS, R_C = R_B + 128 * TS, R_D = R_C + 128 * TS, R_MISC = R_D + 128 * TS;
constexpr int LDS_BYTES = 152 * 1024, LDS_CTL_OFF = LDS_BYTES - 256;
constexpr size_t WS_CTL = 0, CTL_ZERO_BYTES = 16384;
static_assert(R_MISC + 4096 <= LDS_BYTES && pg8::STAGE_BYTES + 3072 <= LDS_BYTES, "LDS map");
constexpr int NWAVES = 8, NT = 512;

#define LAS __attribute__((address_space(3)))
typedef unsigned short bf16;
typedef unsigned v4u __attribute__((ext_vector_type(4)));
typedef unsigned v2u __attribute__((ext_vector_type(2)));
typedef float f32x4 __attribute__((ext_vector_type(4)));
typedef float f32x2 __attribute__((ext_vector_type(2)));
typedef short bf16x8 __attribute__((ext_vector_type(8)));
#define LDS_WAIT() asm volatile("s_waitcnt lgkmcnt(0)" ::: "memory")
__device__ __forceinline__ unsigned pk2(float lo, float hi) { return pg8::cvt_pk_bf16(lo, hi); }
__device__ __forceinline__ float bflo(unsigned w) { return __uint_as_float(w << 16); }
__device__ __forceinline__ float bfhi(unsigned w) { return __uint_as_float(w & 0xffff0000u); }
__device__ __forceinline__ float silu(float x) { return x * __builtin_amdgcn_rcpf(1.0f + __expf(-x)); }
__device__ __forceinline__ float wave_sum(float v) {
#pragma unroll
    for (int o = 1; o < 64; o <<= 1) v += __shfl_xor(v, o);
    return v;
}

#define XB_TMO      128
#define XB_XCNT(j)  (256  + 64 * (j))
#define XB_XSUB(j)  (1280 + 64 * (j))
#define XB_XGEN(j)  (2304 + 64 * (j))
#define XB_TOP      3328
#define XB_TOPGEN   3392
#define XCD_BAR_WORDS 3456
#define XB_SPIN_CAP (1u << 18)

__device__ __forceinline__ unsigned xb_ld(unsigned* p)              { return __hip_atomic_load(p, __ATOMIC_RELAXED, __HIP_MEMORY_SCOPE_AGENT); }
__device__ __forceinline__ unsigned xb_add(unsigned* p, unsigned v) { return __hip_atomic_fetch_add(p, v, __ATOMIC_RELAXED, __HIP_MEMORY_SCOPE_AGENT); }
__device__ __forceinline__ unsigned xb_xcc_id() { return (unsigned)__builtin_amdgcn_s_getreg((3 << 11) | 20) & 0xFu; }
#define XB_SPIN(cond, bar) do { unsigned _sp = 0; while (cond) { __builtin_amdgcn_s_sleep(1); \
    if ((++_sp & 255u) == 0u) { if (xb_ld(&(bar)[XB_TMO])) break; if (_sp > XB_SPIN_CAP) { atomicAdd(&(bar)[XB_TMO], 1u); break; } } } } while (0)

struct XcdBarrier {
    unsigned* bar; unsigned x;
    volatile LAS unsigned* st;
};

__device__ __forceinline__ XcdBarrier xcd_barrier_post(unsigned* bar, volatile LAS unsigned* st) {
    XcdBarrier b; b.bar = bar; b.x = xb_xcc_id(); b.st = st;
    if (threadIdx.x == 0) (void)xb_add(&bar[XB_XCNT(b.x)], 1u);
    return b;
}
__device__ __forceinline__ void xcd_barrier_complete(unsigned* bar, unsigned x, unsigned& nloc, unsigned& nx) {
    const unsigned G = gridDim.x * gridDim.y * gridDim.z;
    unsigned sum, cnt, mine, sp = 0u;
    for (;;) {
        sum = 0u; cnt = 0u; mine = 0u;
#pragma unroll
        for (unsigned j = 0; j < 16; ++j) { const unsigned c = xb_ld(&bar[XB_XCNT(j)]); sum += c; cnt += (c > 0u) ? 1u : 0u; mine = (j == x) ? c : mine; }
        if (sum == G) break;
        __builtin_amdgcn_s_sleep(1);
        if ((++sp & 255u) == 0u) { if (xb_ld(&bar[XB_TMO])) break; if (sp > XB_SPIN_CAP) { atomicAdd(&bar[XB_TMO], 1u); break; } }
    }
    nloc = mine > 0u ? mine : 1u; nx = cnt > 0u ? cnt : 1u;
}

__device__ __forceinline__ void xcd_barrier(const XcdBarrier& b) {
    asm volatile("s_waitcnt vmcnt(0)" ::: "memory");
    __syncthreads();
    if (threadIdx.x == 0) {
        unsigned* bar = b.bar;
        __builtin_amdgcn_s_waitcnt(0);
        unsigned nloc = b.st[0], nx = b.st[1];
        if (nloc == 0u) { xcd_barrier_complete(bar, b.x, nloc, nx); b.st[0] = nloc; b.st[1] = nx; }
        const unsigned old = xb_add(&bar[XB_XSUB(b.x)], 1u);
        const unsigned gen = old / nloc;
        if (old + 1u == (gen + 1u) * nloc) {
            __builtin_amdgcn_fence(__ATOMIC_RELEASE, "agent");
            asm volatile("s_waitcnt vmcnt(0)" ::: "memory");
            const unsigned og = xb_add(&bar[XB_TOP], 1u);
            const unsigned tg = og / nx;
            if (og + 1u == (tg + 1u) * nx) xb_add(&bar[XB_TOPGEN], 1u);
            else XB_SPIN(xb_ld(&bar[XB_TOPGEN]) == tg, bar);
            __builtin_amdgcn_fence(__ATOMIC_ACQUIRE, "agent");
            xb_add(&bar[XB_XGEN(b.x)], 1u);
            asm volatile("s_waitcnt vmcnt(0)" ::: "memory");
        } else {
            XB_SPIN(xb_ld(&bar[XB_XGEN(b.x)]) == gen, bar);
            __builtin_amdgcn_fence(__ATOMIC_ACQUIRE, "agent");
            asm volatile("s_waitcnt vmcnt(0)" ::: "memory");
        }
    }
    __syncthreads();
}

struct Args { const float* in[12]; float* out; unsigned char* ws; int ph_lo, ph_hi; };
struct Ctx {
    LAS unsigned char* lds; int tid, lane, wave, G, bid;
    const float *xp, *xs, *state, *norm_g, *w_in, *w_pool, *pool_scale, *vng, *w_s, *b_s, *w_out, *fng;
    float* out; bf16 *WinT, *WoutT, *WpT, *WsB, *XN, *MIX, *PROJ; float *SSQ, *Y1;
};

__device__ __forceinline__ void p0_transpose_item(const float* W, int K, int N, bf16* WT, const float* ksc, const float* nsc, LAS float* scr, int item, int lane) {
    const int nblk = N / 32, kb = item / nblk, nb = item % nblk, k0 = 64 * kb, n0 = 32 * nb;
#pragma unroll 8
    for (int i = 0; i < 32; ++i) { const int kk = 2 * i + (lane >> 5); float v = W[(size_t)(k0 + kk) * N + n0 + (lane & 31)]; if (ksc) v *= ksc[k0 + kk]; scr[kk * 33 + (lane & 31)] = v; }
    LDS_WAIT(); asm volatile("" ::: "memory");
    const int c = lane & 7;
#pragma unroll
    for (int j = 0; j < 4; ++j) { const int n = (lane >> 3) + 8 * j; const LAS float* s = scr + (8 * c) * 33 + n; const float sc = nsc ? nsc[n0 + n] : 1.0f;
        v4u o; o.x = pk2(s[0 * 33] * sc, s[1 * 33] * sc); o.y = pk2(s[2 * 33] * sc, s[3 * 33] * sc); o.z = pk2(s[4 * 33] * sc, s[5 * 33] * sc); o.w = pk2(s[6 * 33] * sc, s[7 * 33] * sc);
        *(v4u*)(WT + (size_t)(n0 + n) * K + k0 + 8 * c) = o; }
    LDS_WAIT(); asm volatile("" ::: "memory");
}
__device__ __forceinline__ void p0_prologue(Ctx& F) {
    LAS float* scr = (LAS float*)(F.lds + F.wave * 16384);
    const int gw = F.bid * NWAVES + F.wave, NGW = F.G * NWAVES;
    constexpr int I_IN = (D_MODEL / 64) * (D_IN / 32), I_OUT = (D_MODEL / 64) * (D_MODEL / 32), I_P = (GD / 64) * (GD / 32);
    constexpr int NITEMS = DEPTH * (I_IN + I_OUT + NGRP * I_P);
    for (int it = gw; it < NITEMS; it += NGW) {
        int r = it; const int l = r / (I_IN + I_OUT + NGRP * I_P); r -= l * (I_IN + I_OUT + NGRP * I_P);
        if (r < I_IN) { p0_transpose_item(F.w_in + (size_t)l * D_MODEL * D_IN, D_MODEL, D_IN, F.WinT + (size_t)l * D_IN * D_MODEL, F.norm_g + l * D_MODEL, nullptr, scr, r, F.lane); continue; } r -= I_IN;
        if (r < I_OUT) { p0_transpose_item(F.w_out + (size_t)l * D_MODEL * D_MODEL, D_MODEL, D_MODEL, F.WoutT + (size_t)l * D_MODEL * D_MODEL, nullptr, nullptr, scr, r, F.lane); continue; } r -= I_OUT;
        const int g = r / I_P; r -= g * I_P;
        p0_transpose_item(F.w_pool + (size_t)(l * NGRP + g) * GD * GD, GD, GD, F.WpT + (size_t)(l * NGRP + g) * GD * GD, nullptr, F.pool_scale + l * W_A + g * GD, scr, r, F.lane);
    }
    for (int idx = F.bid * NT + F.tid; idx < DEPTH * NHB * CHUNK * CHUNK / 2; idx += F.G * NT) { const int e = idx * 2, i = (e >> 7) & 127, j = e & 127; const f32x2 v = *(const f32x2*)(F.w_s + e);
        *(unsigned*)(F.WsB + e) = pk2(j <= i ? v.x : 0.f, (j + 1) <= i ? v.y : 0.f); }
    for (int m = gw; m < MT; m += NGW) {
        f32x4 v[4]; float s = 0.f;
        if (m < MV) { const f32x4* xr = (const f32x4*)(m < MP ? F.xp + (size_t)m * D_MODEL : F.xs + (size_t)(m - MP) * D_MODEL) + F.lane;
#pragma unroll
            for (int j = 0; j < 4; ++j) { v[j] = xr[64 * j]; s += (v[j].x * v[j].x + v[j].y * v[j].y) + (v[j].z * v[j].z + v[j].w * v[j].w); }
        } else {
#pragma unroll
            for (int j = 0; j < 4; ++j) v[j] = (f32x4){0.f, 0.f, 0.f, 0.f};
        }
        s = wave_sum(s);
        v2u* o8 = (v2u*)(F.XN + (size_t)m * D_MODEL) + F.lane;
#pragma unroll
        for (int j = 0; j < 4; ++j) { v2u w; w.x = pk2(v[j].x, v[j].y); w.y = pk2(v[j].z, v[j].w); o8[64 * j] = w; }
        if (F.lane < 16) F.SSQ[(size_t)m * 16 + F.lane] = F.lane == 0 ? s : 0.f;
    }
}

__device__ __forceinline__ void mix_head(Ctx& F, int l, int c, int h) {
    int tid_l = F.tid; asm volatile("" : "+v"(tid_l)); const int tid = tid_l, lane = tid & 63, wave = __builtin_amdgcn_readfirstlane(tid >> 6), fr = lane & 15, fq = lane >> 4; LAS unsigned char* lds = F.lds;
    const bf16* P = F.PROJ + (size_t)c * CHUNK * D_IN; const bf16* Wsb = F.WsB + (size_t)(l * NHB + h) * CHUNK * CHUNK;
    v4u ru[4], rv[4], rw[4], rg[4];
#pragma unroll
    for (int i = 0; i < 4; ++i) { const int p = tid + NT * i, row = p >> 4, ch = p & 15; const bf16* pr = P + (size_t)row * D_IN + h * HDB + ch * 8;
        ru[i] = *(const v4u*)(pr + 2 * W_A); rv[i] = *(const v4u*)(pr + 2 * W_A + W_B); rw[i] = *(const v4u*)(Wsb + row * CHUNK + ch * 8); }
#pragma unroll
    for (int i = 0; i < 4; ++i) { const int p = tid + NT * i, row = p >> 4, ch = p & 15, o = row * TS + ch * 16;
        *(LAS v4u*)(lds + R_A + o) = ru[i]; *(LAS v4u*)(lds + R_B + o) = rv[i]; *(LAS v4u*)(lds + R_D + o) = rw[i]; }
    __syncthreads();
#pragma unroll
    for (int i = 0; i < 4; ++i) { const int p = tid + NT * i, row = p >> 4, ch = p & 15; rg[i] = *(const v4u*)(P + (size_t)row * D_IN + 2 * W_A + 2 * W_B + h * HDB + ch * 8); }
    const int j = tid & 127, q = tid >> 7;
    float x[32]; float ss = 0.f;
#pragma unroll
    for (int i = 0; i < 4; ++i) { const v4u w = *(const LAS v4u*)(lds + R_B + j * TS + (4 * q + i) * 16);
        x[8 * i + 0] = bflo(w.x); x[8 * i + 1] = bfhi(w.x); x[8 * i + 2] = bflo(w.y); x[8 * i + 3] = bfhi(w.y); x[8 * i + 4] = bflo(w.z); x[8 * i + 5] = bfhi(w.z); x[8 * i + 6] = bflo(w.w); x[8 * i + 7] = bfhi(w.w); }
#pragma unroll
    for (int e = 0; e < 32; ++e) ss += x[e] * x[e];
    LAS float* part = (LAS float*)(lds + R_MISC);
    part[q * 128 + j] = ss;
    __syncthreads();
    ss = (part[j] + part[128 + j]) + (part[256 + j] + part[384 + j]);
    const float rstd = __builtin_amdgcn_rsqf(ss * (1.0f / HDB) + EPS);
    const float* gp = F.vng + l * W_B + h * HDB + q * 32;
    const bool wcv = (c & 15) == 15;
    float* cvp = F.out + O_CVP + ((size_t)(l * BATCH + (c >> 4)) * CHUNK + j) * W_B + h * HDB + q * 32;
#pragma unroll
    for (int i = 0; i < 8; ++i) { const f32x4 g4 = *(const f32x4*)(gp + 4 * i); f32x4 o;
        o.x = x[4 * i] * rstd * g4.x; o.y = x[4 * i + 1] * rstd * g4.y; o.z = x[4 * i + 2] * rstd * g4.z; o.w = x[4 * i + 3] * rstd * g4.w;
        x[4 * i] = o.x; x[4 * i + 1] = o.y; x[4 * i + 2] = o.z; x[4 * i + 3] = o.w;
        if (wcv) *(f32x4*)(cvp + 4 * i) = o; }
#pragma unroll
    for (int e = 0; e < 32; e += 2) { const unsigned w = pk2(x[e], x[e + 1]);
        *(LAS unsigned short*)(lds + R_C + (q * 32 + e) * TS + j * 2) = (unsigned short)(w & 0xffffu);
        *(LAS unsigned short*)(lds + R_C + (q * 32 + e + 1) * TS + j * 2) = (unsigned short)(w >> 16); }
    __syncthreads();
#pragma unroll
    for (int i = 0; i < 4; ++i) { const int p = tid + NT * i, row = p >> 4, ch = p & 15; *(LAS v4u*)(lds + R_B + row * TS + ch * 16) = rg[i]; }
    const int ib0 = (wave >> 1) * 2, db0 = (wave & 1) * 4;
    f32x4 acc[2][4];
#pragma unroll
    for (int a = 0; a < 2; ++a)
#pragma unroll
        for (int b = 0; b < 4; ++b) acc[a][b] = (f32x4){0.f, 0.f, 0.f, 0.f};
#pragma unroll
    for (int ks = 0; ks < 4; ++ks) { bf16x8 af[4], bfr[2];
#pragma unroll
        for (int b = 0; b < 4; ++b) af[b] = *(const LAS bf16x8*)(lds + R_C + (16 * (db0 + b) + fr) * TS + (32 * ks + 8 * fq) * 2);
#pragma unroll
        for (int a = 0; a < 2; ++a) bfr[a] = *(const LAS bf16x8*)(lds + R_D + (16 * (ib0 + a) + fr) * TS + (32 * ks + 8 * fq) * 2);
#pragma unroll
        for (int a = 0; a < 2; ++a)
#pragma unroll
            for (int b = 0; b < 4; ++b) acc[a][b] = __builtin_amdgcn_mfma_f32_16x16x32_bf16(af[b], bfr[a], acc[a][b], 0, 0, 0); }
    __syncthreads();
    const float* bsp = F.b_s + (l * NHB + h) * CHUNK;
#pragma unroll
    for (int a = 0; a < 2; ++a) { const int i = 16 * (ib0 + a) + fr; const float bsv = bsp[i];
#pragma unroll
        for (int b = 0; b < 4; ++b) { const int d = 16 * (db0 + b) + 4 * fq; const int o = i * TS + d * 2;
            const v2u uu = *(const LAS v2u*)(lds + R_A + o), gg = *(const LAS v2u*)(lds + R_B + o);
            const float o0 = bflo(uu.x) * (acc[a][b][0] + bsv) * silu(bflo(gg.x)), o1 = bfhi(uu.x) * (acc[a][b][1] + bsv) * silu(bfhi(gg.x));
            const float o2 = bflo(uu.y) * (acc[a][b][2] + bsv) * silu(bflo(gg.y)), o3 = bfhi(uu.y) * (acc[a][b][3] + bsv) * silu(bfhi(gg.y));
            v2u w; w.x = pk2(o0, o1); w.y = pk2(o2, o3); *(LAS v2u*)(lds + R_A + o) = w; } }
    __syncthreads();
    bf16* Mx = F.MIX + (size_t)c * CHUNK * D_MODEL + W_A + h * HDB;
#pragma unroll
    for (int i = 0; i < 4; ++i) { const int p = tid + NT * i, row = p >> 4, ch = p & 15; *(v4u*)(Mx + (size_t)row * D_MODEL + ch * 8) = *(const LAS v4u*)(lds + R_A + row * TS + ch * 16); }
    __syncthreads();
}
__device__ __forceinline__ void mix_pool(Ctx& F, int l, int c, int g) {
    int tid_l = F.tid; asm volatile("" : "+v"(tid_l)); const int tid = tid_l, lane = tid & 63, wave = __builtin_amdgcn_readfirstlane(tid >> 6), fr = lane & 15, fq = lane >> 4; LAS unsigned char* lds = F.lds;
    const bool first = (c & 15) == 0; const int w = 2 << g;
    const bf16* P = F.PROJ + (size_t)c * CHUNK * D_IN + g * GD; const bf16* Wp = F.WpT + (size_t)(l * NGRP + g) * GD * GD;
    v4u ra[4], rg[4], rw[4], rh = (v4u){0u, 0u, 0u, 0u};
#pragma unroll
    for (int i = 0; i < 4; ++i) { const int p = tid + NT * i, row = p >> 4, ch = p & 15; const bf16* pr = P + (size_t)row * D_IN + ch * 8;
        ra[i] = *(const v4u*)pr; rg[i] = *(const v4u*)(pr + W_A); rw[i] = *(const v4u*)(Wp + row * GD + ch * 8); }
    if (tid < 256 && !first) rh = *(const v4u*)(P - (size_t)16 * D_IN + (size_t)(tid >> 4) * D_IN + (tid & 15) * 8);
#pragma unroll
    for (int i = 0; i < 4; ++i) { const int p = tid + NT * i, row = p >> 4, ch = p & 15, o = row * TS + ch * 16;
        *(LAS v4u*)(lds + R_A + 16 * TS + o) = ra[i]; *(LAS v4u*)(lds + R_B + o) = rg[i]; *(LAS v4u*)(lds + R_D + o) = rw[i]; }
    if (tid < 256) *(LAS v4u*)(lds + R_A + (tid >> 4) * TS + (tid & 15) * 16) = rh;
    __syncthreads();
    {
        const int cg4 = tid & 31, t0 = (tid >> 5) * 8; const LAS unsigned char* ap = lds + R_A + 16 * TS + cg4 * 8;
        f32x4 S = (f32x4){0.f, 0.f, 0.f, 0.f};
        for (int k = 0; k < w; ++k) { const v2u a = *(const LAS v2u*)(ap + (t0 - k) * TS); S.x += bflo(a.x); S.y += bfhi(a.x); S.z += bflo(a.y); S.w += bfhi(a.y); }
#pragma unroll
        for (int tt = 0; tt < 8; ++tt) { const int t = t0 + tt; const v2u a = *(const LAS v2u*)(ap + t * TS);
            const int cnt = first ? ((t + 1) < w ? (t + 1) : w) : w; const float ic = 1.0f / (float)cnt;
            v2u o; o.x = pk2(S.x * ic - bflo(a.x), S.y * ic - bfhi(a.x)); o.y = pk2(S.z * ic - bflo(a.y), S.w * ic - bfhi(a.y));
            *(LAS v2u*)(lds + R_C + t * TS + cg4 * 8) = o;
            if (tt < 7) { const v2u n = *(const LAS v2u*)(ap + (t + 1) * TS), d = *(const LAS v2u*)(ap + (t + 1 - w) * TS);
                S.x += bflo(n.x) - bflo(d.x); S.y += bfhi(n.x) - bfhi(d.x); S.z += bflo(n.y) - bflo(d.y); S.w += bfhi(n.y) - bfhi(d.y); } }
        if ((c & 15) == 15 && tid < POOL_BUF * 32) { const int r = tid >> 5; const v2u a = *(const LAS v2u*)(ap + (CHUNK - POOL_BUF + r) * TS);
            *(f32x4*)(F.out + O_PP + ((size_t)(l * BATCH + (c >> 4)) * POOL_BUF + r) * W_A + g * GD + cg4 * 4) = (f32x4){bflo(a.x), bfhi(a.x), bflo(a.y), bfhi(a.y)}; }
    }
    __syncthreads();
    const int tb0 = (wave >> 1) * 2, db0 = (wave & 1) * 4;
    f32x4 acc[2][4];
#pragma unroll
    for (int a = 0; a < 2; ++a)
#pragma unroll
        for (int b = 0; b < 4; ++b) acc[a][b] = (f32x4){0.f, 0.f, 0.f, 0.f};
#pragma unroll
    for (int ks = 0; ks < 4; ++ks) { bf16x8 af[4], bfr[2];
#pragma unroll
        for (int b = 0; b < 4; ++b) af[b] = *(const LAS bf16x8*)(lds + R_D + (16 * (db0 + b) + fr) * TS + (32 * ks + 8 * fq) * 2);
#pragma unroll
        for (int a = 0; a < 2; ++a) bfr[a] = *(const LAS bf16x8*)(lds + R_C + (16 * (tb0 + a) + fr) * TS + (32 * ks + 8 * fq) * 2);
#pragma unroll
        for (int a = 0; a < 2; ++a)
#pragma unroll
            for (int b = 0; b < 4; ++b) acc[a][b] = __builtin_amdgcn_mfma_f32_16x16x32_bf16(af[b], bfr[a], acc[a][b], 0, 0, 0); }
#pragma unroll
    for (int a = 0; a < 2; ++a) { const int t = 16 * (tb0 + a) + fr;
#pragma unroll
        for (int b = 0; b < 4; ++b) { const int d = 16 * (db0 + b) + 4 * fq; const int o = t * TS + d * 2;
            const v2u gg = *(const LAS v2u*)(lds + R_B + o);
            v2u wv; wv.x = pk2(acc[a][b][0] * silu(bflo(gg.x)), acc[a][b][1] * silu(bfhi(gg.x))); wv.y = pk2(acc[a][b][2] * silu(bflo(gg.y)), acc[a][b][3] * silu(bfhi(gg.y)));
            *(LAS v2u*)(lds + R_B + o) = wv; } }
    __syncthreads();
    bf16* Mx = F.MIX + (size_t)c * CHUNK * D_MODEL + g * GD;
#pragma unroll
    for (int i = 0; i < 4; ++i) { const int p = tid + NT * i, row = p >> 4, ch = p & 15; *(v4u*)(Mx + (size_t)row * D_MODEL + ch * 8) = *(const LAS v4u*)(lds + R_B + row * TS + ch * 16); }
    __syncthreads();
}
__device__ __forceinline__ void mix_pool_sample(Ctx& F, int l, int g, int sb) {
    int tid_l = F.tid; asm volatile("" : "+v"(tid_l)); const int tid = tid_l, lane = tid & 63, wave = __builtin_amdgcn_readfirstlane(tid >> 6), fr = lane & 15, fq = lane >> 4; LAS unsigned char* lds = F.lds;
    const int w = 2 << g; const int sl = tid >> 5, c4 = tid & 31, s = sb * 16 + sl;
    const bf16* Wp = F.WpT + (size_t)(l * NGRP + g) * GD * GD;
    v4u rw[4];
#pragma unroll
    for (int i = 0; i < 4; ++i) { const int p = tid + NT * i, row = p >> 4, ch = p & 15; rw[i] = *(const v4u*)(Wp + row * GD + ch * 8); }
    const bf16* pr = F.PROJ + (size_t)(MP + s) * D_IN + g * GD;
    const v2u a = *(const v2u*)(pr + c4 * 4);
    v4u rgate = (v4u){0u, 0u, 0u, 0u};
    if (tid < 256) rgate = *(const v4u*)(F.PROJ + (size_t)(MP + sb * 16 + (tid >> 4)) * D_IN + W_A + g * GD + (tid & 15) * 8);
    const f32x4 av = (f32x4){bflo(a.x), bfhi(a.x), bflo(a.y), bfhi(a.y)};
    const float* sp = F.state + ((size_t)(l * DEC_BATCH + s) * POOL_BUF) * W_A + g * GD + c4 * 4;
    float* op = F.out + O_PS + ((size_t)(l * DEC_BATCH + s) * POOL_BUF) * W_A + g * GD + c4 * 4;
    f32x4 S = av;
#pragma unroll
    for (int r = 0; r < POOL_BUF; ++r) { const f32x4 v = *(const f32x4*)(sp + (size_t)r * W_A);
        if (r >= 16 - w) S += v;
        if (r >= 1) *(f32x4*)(op + (size_t)(r - 1) * W_A) = v; }
    *(f32x4*)(op + (size_t)(POOL_BUF - 1) * W_A) = av;
    const float ic = 1.0f / (float)w;
    { v2u o; o.x = pk2(S.x * ic - av.x, S.y * ic - av.y); o.y = pk2(S.z * ic - av.z, S.w * ic - av.w); *(LAS v2u*)(lds + R_C + sl * TS + c4 * 8) = o; }
#pragma unroll
    for (int i = 0; i < 4; ++i) { const int p = tid + NT * i, row = p >> 4, ch = p & 15; *(LAS v4u*)(lds + R_D + row * TS + ch * 16) = rw[i]; }
    if (tid < 256) *(LAS v4u*)(lds + R_B + (tid >> 4) * TS + (tid & 15) * 16) = rgate;
    __syncthreads();
    f32x4 acc = (f32x4){0.f, 0.f, 0.f, 0.f};
#pragma unroll
    for (int ks = 0; ks < 4; ++ks) { const bf16x8 af = *(const LAS bf16x8*)(lds + R_D + (16 * wave + fr) * TS + (32 * ks + 8 * fq) * 2), bfr = *(const LAS bf16x8*)(lds + R_C + fr * TS + (32 * ks + 8 * fq) * 2);
        acc = __builtin_amdgcn_mfma_f32_16x16x32_bf16(af, bfr, acc, 0, 0, 0); }
    { const int o = fr * TS + (16 * wave + 4 * fq) * 2; const v2u gg = *(const LAS v2u*)(lds + R_B + o);
      v2u wv; wv.x = pk2(acc[0] * silu(bflo(gg.x)), acc[1] * silu(bfhi(gg.x))); wv.y = pk2(acc[2] * silu(bflo(gg.y)), acc[3] * silu(bfhi(gg.y)));
      *(LAS v2u*)(lds + R_B + o) = wv; }
    __syncthreads();
    if (tid < 256) *(v4u*)(F.MIX + (size_t)(MP + sb * 16 + (tid >> 4)) * D_MODEL + g * GD + (tid & 15) * 8) = *(const LAS v4u*)(lds + R_B + (tid >> 4) * TS + (tid & 15) * 16);
    __syncthreads();
}
__device__ __forceinline__ void mix_head_sample(Ctx& F, int l, int h) {
    int tid_l = F.tid; asm volatile("" : "+v"(tid_l)); const int tid = tid_l, s = tid >> 2, q = tid & 3;
    const bf16* pr = F.PROJ + (size_t)(MP + s) * D_IN + 2 * W_A + h * HDB + q * 32;
    v4u ru[4], rv[4], rg[4];
#pragma unroll
    for (int i = 0; i < 4; ++i) { ru[i] = *(const v4u*)(pr + 8 * i); rv[i] = *(const v4u*)(pr + W_B + 8 * i); rg[i] = *(const v4u*)(pr + 2 * W_B + 8 * i); }
    float ss = 0.f;
#pragma unroll
    for (int i = 0; i < 4; ++i) { const v4u w = rv[i]; float t;
        t = bflo(w.x); ss += t * t; t = bfhi(w.x); ss += t * t; t = bflo(w.y); ss += t * t; t = bfhi(w.y); ss += t * t; t = bflo(w.z); ss += t * t; t = bfhi(w.z); ss += t * t; t = bflo(w.w); ss += t * t; t = bfhi(w.w); ss += t * t; }
    ss += __shfl_xor(ss, 1); ss += __shfl_xor(ss, 2);
    const float rstd = __builtin_amdgcn_rsqf(ss * (1.0f / HDB) + EPS);
    const float w00 = F.w_s[(size_t)(l * NHB + h) * CHUNK * CHUNK], b0 = F.b_s[(l * NHB + h) * CHUNK];
    const float* gp = F.vng + l * W_B + h * HDB + q * 32;
    float* cvp = F.out + O_CVS + (size_t)(l * DEC_BATCH + s) * W_B + h * HDB + q * 32;
    bf16* mx = F.MIX + (size_t)(MP + s) * D_MODEL + W_A + h * HDB + q * 32;
#pragma unroll
    for (int i = 0; i < 4; ++i) { const v4u wu = ru[i], wv = rv[i], wg = rg[i]; const f32x4 g0 = *(const f32x4*)(gp + 8 * i), g1 = *(const f32x4*)(gp + 8 * i + 4);
        f32x4 n0, n1; n0.x = bflo(wv.x) * rstd * g0.x; n0.y = bfhi(wv.x) * rstd * g0.y; n0.z = bflo(wv.y) * rstd * g0.z; n0.w = bfhi(wv.y) * rstd * g0.w;
        n1.x = bflo(wv.z) * rstd * g1.x; n1.y = bfhi(wv.z) * rstd * g1.y; n1.z = bflo(wv.w) * rstd * g1.z; n1.w = bfhi(wv.w) * rstd * g1.w;
        *(f32x4*)(cvp + 8 * i) = n0; *(f32x4*)(cvp + 8 * i + 4) = n1;
        v4u o;
        o.x = pk2(bflo(wu.x) * (w00 * n0.x + b0) * silu(bflo(wg.x)), bfhi(wu.x) * (w00 * n0.y + b0) * silu(bfhi(wg.x)));
        o.y = pk2(bflo(wu.y) * (w00 * n0.z + b0) * silu(bflo(wg.y)), bfhi(wu.y) * (w00 * n0.w + b0) * silu(bfhi(wg.y)));
        o.z = pk2(bflo(wu.z) * (w00 * n1.x + b0) * silu(bflo(wg.z)), bfhi(wu.z) * (w00 * n1.y + b0) * silu(bfhi(wg.z)));
        o.w = pk2(bflo(wu.w) * (w00 * n1.z + b0) * silu(bflo(wg.w)), bfhi(wu.w) * (w00 * n1.w + b0) * silu(bfhi(wg.w)));
        *(v4u*)(mx + 8 * i) = o; }
}
constexpr int NU_PROMPT = NCHUNK * 8, NU_SPOOL = NGRP * 8, NU_SHEAD = NHB, NU_MIX = NU_PROMPT + NU_SPOOL + NU_SHEAD;
__device__ __forceinline__ void p2_mixers(Ctx& F, int l) {
    for (int u = F.bid; u < NU_MIX; u += F.G) {
        if (u < NU_PROMPT) { const int c = u >> 3, p = u & 7; if (p < 4) mix_pool(F, l, c, p); else mix_head(F, l, c, p - 4); }
        else if (u < NU_PROMPT + NU_SPOOL) { const int r = u - NU_PROMPT; mix_pool_sample(F, l, r >> 3, r & 7); }
        else mix_head_sample(F, l, u - NU_PROMPT - NU_SPOOL);
    }
}
__device__ __forceinline__ void p3_sample_out(Ctx& F, int l) {
    if (F.bid >= 128) return;
    int tid_l = F.tid; asm volatile("" : "+v"(tid_l)); const int tid = tid_l, lane = tid & 63, wave = __builtin_amdgcn_readfirstlane(tid >> 6), fr = lane & 15, fq = lane >> 4; LAS unsigned char* lds = F.lds;
    const int tr = F.bid >> 4, tc = F.bid & 15; const bool last = l == DEPTH - 1;
    const bf16* A = F.MIX + (size_t)(MP + 16 * tr + fr) * D_MODEL + 128 * wave + 8 * fq;
    const bf16* B = F.WoutT + (size_t)l * D_MODEL * D_MODEL + (size_t)(64 * tc + fr) * D_MODEL + 128 * wave + 8 * fq;
    f32x4 acc[4];
#pragma unroll
    for (int nb = 0; nb < 4; ++nb) acc[nb] = (f32x4){0.f, 0.f, 0.f, 0.f};
#pragma unroll
    for (int ks = 0; ks < 4; ++ks) { const bf16x8 af = *(const bf16x8*)(A + 32 * ks);
#pragma unroll
        for (int nb = 0; nb < 4; ++nb) { const bf16x8 bfr = *(const bf16x8*)(B + (size_t)(16 * nb) * D_MODEL + 32 * ks); acc[nb] = __builtin_amdgcn_mfma_f32_16x16x32_bf16(bfr, af, acc[nb], 0, 0, 0); } }
#pragma unroll
    for (int nb = 0; nb < 4; ++nb) *(LAS f32x4*)(lds + ((wave * 16 + fr) * 64 + 16 * nb + 4 * fq) * 4) = acc[nb];
    __syncthreads();
    const int s = tid >> 5, n2 = (tid & 31) * 2; f32x2 sum = (f32x2){0.f, 0.f};
#pragma unroll
    for (int wv = 0; wv < 8; ++wv) sum += *(const LAS f32x2*)(lds + ((wv * 16 + s) * 64 + n2) * 4);
    const int row = MP + 16 * tr + s, col = 64 * tc + n2;
    const f32x2 bs = *(const f32x2*)(l == 0 ? F.xs + (size_t)(16 * tr + s) * D_MODEL + col : F.Y1 + (size_t)row * D_MODEL + col);
    const f32x2 o = bs + sum;
    if (last) *(f32x2*)(F.out + (size_t)row * D_MODEL + col) = o;
    else { *(f32x2*)(F.Y1 + (size_t)row * D_MODEL + col) = o; *(unsigned*)(F.XN + (size_t)row * D_MODEL + col) = pk2(o.x, o.y);
        float q = o.x * o.x + o.y * o.y;
#pragma unroll
        for (int of = 1; of < 32; of <<= 1) q += __shfl_xor(q, of);
        if ((tid & 31) == 0) F.SSQ[(size_t)row * 16 + tc] = q; }
    __syncthreads();
}
__device__ __forceinline__ void p4_final(Ctx& F) {
    const int gw = F.bid * NWAVES + F.wave, NGW = F.G * NWAVES;
    f32x4 g[4];
#pragma unroll
    for (int j = 0; j < 4; ++j) g[j] = ((const f32x4*)F.fng)[F.lane + 64 * j];
    for (int m = gw; m < MV; m += NGW) { f32x4* xr = (f32x4*)(F.out + (size_t)m * D_MODEL) + F.lane; f32x4 v[4]; float s = 0.f;
#pragma unroll
        for (int j = 0; j < 4; ++j) { v[j] = xr[64 * j]; s += (v[j].x * v[j].x + v[j].y * v[j].y) + (v[j].z * v[j].z + v[j].w * v[j].w); }
        const float rstd = __builtin_amdgcn_rsqf(wave_sum(s) * (1.0f / D_MODEL) + EPS);
#pragma unroll
        for (int j = 0; j < 4; ++j) xr[64 * j] = v[j] * rstd * g[j]; }
}

#ifndef MK_REPEAT_MASK
#define MK_REPEAT_MASK 0
#endif
#ifndef MK_COOP
#define MK_COOP 1
#endif
constexpr int N_PHASES = 8;
__global__ void __launch_bounds__(NT, 2) fwd_megakernel(Args args) {
    extern __shared__ __attribute__((aligned(16))) unsigned char lds_raw[];
    Ctx F;
    F.lds = (LAS unsigned char*)lds_raw; F.tid = threadIdx.x; F.lane = F.tid & 63; F.wave = __builtin_amdgcn_readfirstlane(F.tid >> 6); F.G = gridDim.x; F.bid = blockIdx.x;
    F.xp = args.in[0]; F.xs = args.in[1]; F.state = args.in[2]; F.norm_g = args.in[3]; F.w_in = args.in[4]; F.w_pool = args.in[5]; F.pool_scale = args.in[6]; F.vng = args.in[7];
    F.w_s = args.in[8]; F.b_s = args.in[9]; F.w_out = args.in[10]; F.fng = args.in[11]; F.out = args.out;
    unsigned char* ws = args.ws;
    F.WinT = (bf16*)(ws + WS_WIN); F.WoutT = (bf16*)(ws + WS_WOUT); F.WpT = (bf16*)(ws + WS_WP); F.WsB = (bf16*)(ws + WS_WSB); F.SSQ = (float*)(ws + WS_SSQ);
    F.XN = (bf16*)(ws + WS_XN); F.MIX = (bf16*)(ws + WS_MIX); F.PROJ = (bf16*)(ws + WS_PROJ); F.Y1 = (float*)(ws + WS_Y1);
    const int lo = args.ph_lo, hi = args.ph_hi;
#if MK_COOP
    volatile LAS unsigned* misc = (volatile LAS unsigned*)(F.lds + LDS_CTL_OFF);
    if (F.tid < 64) misc[F.tid] = 0u;
    __syncthreads();
    XcdBarrier bar = xcd_barrier_post((unsigned*)(ws + WS_CTL), misc + 8);
    if (hi > 1000) cg::this_grid().sync();
#define SEAM(k) do { if (lo <= (k) && (k) + 1 < hi) xcd_barrier(bar); } while (0)
#else
#define SEAM(k) do { } while (0)
#endif
#define IN(k) (lo <= (k) && (k) < hi)
    if (IN(0)) { p0_prologue(F); SEAM(0); }
    for (int l = 0; l < DEPTH; ++l) {
        if (IN(1 + 3 * l)) {
            pg8::Gemm g{F.XN, F.WinT + (size_t)l * D_IN * D_MODEL, MT, D_IN, D_MODEL}; pg8::StaticOrder S; S.init(MT, D_IN, F.G, F.bid);
            LAS float* rs = (LAS float*)(F.lds + pg8::STAGE_BYTES); int pmv[3] = {-1, -1, -1};
#pragma unroll
            for (int i = 0; i < 3; ++i) { pg8::Unit u; if (S.next(i, u)) { pmv[i] = u.pm; const int r = F.tid >> 1, hf = F.tid & 1; const f32x4* sp = (const f32x4*)(F.SSQ + (size_t)(u.pm * 256 + r) * 16 + hf * 8);
                const f32x4 s0 = sp[0], s1 = sp[1]; float s = ((s0[0] + s0[1]) + (s0[2] + s0[3])) + ((s1[0] + s1[1]) + (s1[2] + s1[3])); s += __shfl_xor(s, 1);
                if (hf == 0) rs[i * 256 + r] = __builtin_amdgcn_rsqf(s * (1.0f / D_MODEL) + EPS); } }
            __syncthreads();
            pg8::EpiProj E{F.PROJ, D_IN, rs, pmv[0], pmv[1]};
            pg8::gemm_phase<pg8::EpiProj, pg8::StaticOrder, true, true>(F.lds, g, S, E);
            SEAM(1 + 3 * l);
        }
        if (IN(2 + 3 * l)) { p2_mixers(F, l); SEAM(2 + 3 * l); }
        if (IN(3 + 3 * l)) {
            pg8::Gemm g{F.MIX, F.WoutT + (size_t)l * D_MODEL * D_MODEL, MP, D_MODEL, D_MODEL}; pg8::StaticOrder S; S.init(MP, D_MODEL, F.G, F.bid);
            pg8::EpiOut E{l == 0 ? F.xp : F.Y1, l == DEPTH - 1 ? F.out : F.Y1, F.XN, F.SSQ, D_MODEL, l == DEPTH - 1 ? 1 : 0};
            pg8::gemm_phase<pg8::EpiOut, pg8::StaticOrder, true, true>(F.lds, g, S, E);
            p3_sample_out(F, l);
            SEAM(3 + 3 * l);
        }
    }
    if (IN(7)) p4_final(F);
}

extern "C" void kernel_launch(void* const* d_in, const int* in_sizes, int n_in, void* d_out, int out_size, void* d_ws, size_t ws_size, hipStream_t stream) {
    static int grid = 0;
    if (grid == 0) {
        if (n_in != 12 || ws_size < WS_END) { fprintf(stderr, "kernel_launch: unexpected inputs (n_in %d, ws %zu)\n", n_in, ws_size); grid = -1; return; }
        int dev = 0, cus = 0, per_cu = 0;
        if (hipGetDevice(&dev) != hipSuccess || hipDeviceGetAttribute(&cus, hipDeviceAttributeMultiprocessorCount, dev) != hipSuccess) { grid = -1; return; }
        if (hipFuncSetAttribute((const void*)fwd_megakernel, hipFuncAttributeMaxDynamicSharedMemorySize, LDS_BYTES) != hipSuccess) { fprintf(stderr, "kernel_launch: hipFuncSetAttribute failed\n"); grid = -1; return; }
        if (hipOccupancyMaxActiveBlocksPerMultiprocessor(&per_cu, (const void*)fwd_megakernel, NT, LDS_BYTES) != hipSuccess || per_cu < 1) { fprintf(stderr, "kernel_launch: occupancy query says %d\n", per_cu); per_cu = 1; }
        (void)hipGetLastError();
        grid = cus;
    }
    if (grid < 0) return;
    Args a{};
#if MK_COOP
    if (hipMemsetAsync((char*)d_ws + WS_CTL, 0, CTL_ZERO_BYTES, stream) != hipSuccess) { fprintf(stderr, "kernel_launch: hipMemsetAsync failed\n"); return; }
#endif
    for (int i = 0; i < 12; ++i) a.in[i] = (const float*)d_in[i];
    a.out = (float*)d_out; a.ws = (unsigned char*)d_ws;
#if MK_COOP
    a.ph_lo = 0; a.ph_hi = N_PHASES;
    void* kargs[] = {&a};
    hipError_t e = hipLaunchCooperativeKernel((const void*)fwd_megakernel, dim3(grid), dim3(NT), kargs, LDS_BYTES, stream);
    if (e != hipSuccess) fprintf(stderr, "kernel_launch: cooperative launch failed: %s (grid %d)\n", hipGetErrorString(e), grid);
#else
    for (int p = 0; p < N_PHASES; ++p) { a.ph_lo = p; a.ph_hi = p + 1; const int reps = ((MK_REPEAT_MASK >> p) & 1) ? 2 : 1;
        for (int r = 0; r < reps; ++r) hipLaunchKernelGGL(fwd_megakernel, dim3(grid), dim3(NT), LDS_BYTES, stream, a); }
#endif
}
```

```cpp
#include <hip/hip_runtime.h>
#include <hip/hip_cooperative_groups.h>
#include <cstdio>
#include <cstdint>
namespace cg = cooperative_groups;
namespace pg8 {
#define PG8_LAS __attribute__((address_space(3)))
typedef unsigned short bf16_t;
typedef short bf16x8 __attribute__((ext_vector_type(8)));
typedef float f32x4 __attribute__((ext_vector_type(4)));
typedef unsigned u32x4 __attribute__((ext_vector_type(4)));
constexpr int BM = 256, BK = 64, HALF = 128, HTB = HALF * BK * 2  , STAGE_BYTES = 8 * HTB, NXCD = 8, WGM = 8;

__host__ __device__ __forceinline__ int lds_byte(int r, int c) { const int st = (r >> 4) * 2 + (c >> 5), rr = r & 15, cc = c & 31, ob = rr * 64 + cc * 2; return st * 1024 + (ob ^ (((ob >> 9) & 1) << 5)); }
__host__ __device__ __forceinline__ void stage_rc(int b, int& R, int& C) { const int st = b / 1024, sb = b % 1024, swz = sb ^ (((sb >> 9) & 1) << 5); R = (st >> 1) * 16 + swz / 64; C = (st & 1) * 32 + (swz % 64) / 2; }
__host__ __device__ __forceinline__ int perm32(int rho) { const int n = rho >> 4, i = rho & 15; return 8 * (i >> 2) + 4 * n + (i & 3); }

struct Unit { int pm, pn; };
struct Gemm { const bf16_t* A; const bf16_t* Bt; int M, N, K; };

struct StaticOrder {
    int nM, nN, nwg, G, c;
    __host__ __device__ void init(int M, int N, int G_, int c_) { nM = M / BM; nN = N / BM; nwg = nM * nN; G = G_; c = c_; }
    __host__ __device__ bool next(int i, Unit& u) const {
        const long L = (long)i * G + c; if (L >= nwg) return false;
        int wgid = (int)L; { const int q = nwg / NXCD, r = nwg % NXCD, xcd = wgid % NXCD, off = wgid / NXCD; wgid = (xcd < r ? xcd * (q + 1) : r * (q + 1) + (xcd - r) * q) + off; }
        const int nig = WGM * nN, gid = wgid / nig, fm = gid * WGM, gsz = (nM - fm) < WGM ? (nM - fm) : WGM;
        u.pm = fm + ((wgid % nig) % gsz); u.pn = (wgid % nig) / gsz; return true;
    }
    __device__ __forceinline__ void a_ready(const Unit&) const {}
    __device__ __forceinline__ void done(const Unit&) const {}
};

__device__ __forceinline__ unsigned cvt_pk_bf16(float lo, float hi) { unsigned r; asm volatile("v_cvt_pk_bf16_f32 %0, %1, %2" : "=v"(r) : "v"(lo), "v"(hi)); return r; }
typedef unsigned u32x2 __attribute__((ext_vector_type(2)));
struct EpiProj {
    static constexpr bool PERM = true, AFTER_DRAIN = false;
    bf16_t* O; int ldc; const PG8_LAS float* rs; int pm0, pm1;
    __device__ __forceinline__ void operator()(const f32x4 (&acc)[2][2][4][2], const Unit& u, int wr, int wc, int fr, int fq) const {
        const int row0 = u.pm * BM + wr * 64 + fr, col0 = u.pn * BM + wc * 32 + 8 * fq;
        const PG8_LAS float* rp = rs + (u.pm == pm0 ? 0 : (u.pm == pm1 ? 256 : 512)) + wr * 64 + fr;
#pragma unroll
        for (int ai = 0; ai < 2; ++ai)
#pragma unroll
            for (int m = 0; m < 4; ++m) { const int row = row0 + ai * HALF + m * 16; const float rsv = rp[ai * HALF + m * 16];
                bf16_t* rowp = O + (size_t)row * ldc + col0;
#pragma unroll
                for (int bj = 0; bj < 2; ++bj) { const f32x4 v0 = acc[ai][bj][m][0] * rsv, v1 = acc[ai][bj][m][1] * rsv;
                    u32x4 w; w.x = cvt_pk_bf16(v0[0], v0[1]); w.y = cvt_pk_bf16(v0[2], v0[3]); w.z = cvt_pk_bf16(v1[0], v1[1]); w.w = cvt_pk_bf16(v1[2], v1[3]);
                    *(u32x4*)(rowp + bj * HALF) = w; } }
    }
};
struct EpiOut {
    static constexpr bool PERM = false, AFTER_DRAIN = false;
    float* out; bf16_t* xn; float* ssq; int ldc; int last;
    __device__ __forceinline__ void operator()(const f32x4 (&acc)[2][2][4][2], const Unit& u, int wr, int wc, int fr, int fq) const {
        const int col0 = u.pn * BM + wc * 32 + 4 * fq;
#pragma unroll
        for (int ai = 0; ai < 2; ++ai)
#pragma unroll
            for (int m = 0; m < 4; ++m) { const int row = u.pm * BM + ai * HALF + wr * 64 + m * 16 + fr; const size_t off = (size_t)row * ldc + col0; float q = 0.f;
#pragma unroll
                for (int bj = 0; bj < 2; ++bj)
#pragma unroll
                    for (int n = 0; n < 2; ++n) { const u32x2 bw = *(const u32x2*)(xn + off + bj * HALF + n * 16);
                        const f32x4 bs = (f32x4){__uint_as_float(bw.x << 16), __uint_as_float(bw.x & 0xffff0000u), __uint_as_float(bw.y << 16), __uint_as_float(bw.y & 0xffff0000u)};
                        const f32x4 o = bs + acc[ai][bj][m][n];
                        if (last) *(f32x4*)(out + off + bj * HALF + n * 16) = o;
                        else { q += (o[0] * o[0] + o[1] * o[1]) + (o[2] * o[2] + o[3] * o[3]); u32x2 w; w.x = cvt_pk_bf16(o[0], o[1]); w.y = cvt_pk_bf16(o[2], o[3]); *(u32x2*)(xn + off + bj * HALF + n * 16) = w; } }
                if (!last) { q += __shfl_xor(q, 16); q += __shfl_xor(q, 32); if (fq == 0) ssq[(size_t)row * 16 + u.pn * 4 + wc] = q; } }
    }
};
template <class Epi, class Sched, bool ALIGN_EPI = false, bool SP2 = false>
__device__ __forceinline__ void gemm_phase(PG8_LAS unsigned char* lds, const Gemm g, const Sched& S, const Epi& E) {
    int tid_l = threadIdx.x; asm volatile("" : "+v"(tid_l));
    const int tid = tid_l, wid = __builtin_amdgcn_readfirstlane(tid >> 6), lane = tid & 63, wr = wid >> 2, wc = wid & 3, fr = lane & 15, fq = lane >> 4;
    const int K = g.K, nt = K / BK;
    unsigned voffA[2], voffB[2];
#pragma unroll
    for (int i = 0; i < 2; ++i) { int R, C; stage_rc(tid * 16 + i * 8192, R, C); const int Rb = Epi::PERM ? ((R & ~31) + perm32(R & 31)) : R;
        voffA[i] = (unsigned)(R * K + C) * 2u; voffB[i] = (unsigned)(Rb * K + C) * 2u; }
    const size_t kstep = (size_t)(BK * 2);
    const size_t hstep = (size_t)HALF * K * 2;
    const size_t tstep = 2 * hstep;
    const unsigned ldsw = (unsigned)wid * 1024u;
    const int aoff = lds_byte(wr * 64 + fr, fq * 8), boff = lds_byte(wc * 32 + fr, fq * 8);
#define PG8_SA(b, h) (((b) * 2 + (h)) * HTB)
#define PG8_SB(b, h) ((4 + (b) * 2 + (h)) * HTB)
#define PG8_STAGE(bufoff, gbase, voff) do { _Pragma("unroll") for (int _i = 0; _i < 2; ++_i) \
        __builtin_amdgcn_global_load_lds((const unsigned*)((const char*)(gbase) + (voff)[_i]), (PG8_LAS unsigned*)(lds + (bufoff) + ldsw + _i * 8192), 16, 0, 0); } while (0)
#define PG8_LDA(dst, b, h) do { _Pragma("unroll") for (int m = 0; m < 4; ++m) _Pragma("unroll") for (int k = 0; k < 2; ++k) dst[m][k] = *(const PG8_LAS bf16x8*)(lds + PG8_SA(b, h) + aoff + m * 2048 + k * 1024); } while (0)
#define PG8_LDB(dst, b, h) do { _Pragma("unroll") for (int n = 0; n < 2; ++n) _Pragma("unroll") for (int k = 0; k < 2; ++k) dst[n][k] = *(const PG8_LAS bf16x8*)(lds + PG8_SB(b, h) + boff + n * 2048 + k * 1024); } while (0)
#define PG8_MMA(ai, bj, At, Bt) do { __builtin_amdgcn_s_setprio(1); _Pragma("unroll") for (int m = 0; m < 4; ++m) _Pragma("unroll") for (int n = 0; n < 2; ++n) _Pragma("unroll") for (int k = 0; k < 2; ++k) \
        acc[ai][bj][m][n] = __builtin_amdgcn_mfma_f32_16x16x32_bf16(Bt[n][k], At[m][k], acc[ai][bj][m][n], 0, 0, 0); __builtin_amdgcn_s_setprio(0); } while (0)
#define PG8_WAIT_V(n) asm volatile("s_waitcnt vmcnt(" #n ")" ::: "memory")
#define PG8_WAIT_L(n) asm volatile("s_waitcnt lgkmcnt(" #n ")" ::: "memory")
#define PG8_BAR __builtin_amdgcn_s_barrier()
#define PG8_SCHED __builtin_amdgcn_sched_barrier(0)
    Unit cur, nxt; int ui = 0;
    if (!S.next(0, cur)) return;
    f32x4 acc[2][2][4][2];
#pragma unroll
    for (int a = 0; a < 2; ++a)
#pragma unroll
        for (int b = 0; b < 2; ++b)
#pragma unroll
            for (int m = 0; m < 4; ++m)
#pragma unroll
                for (int n = 0; n < 2; ++n) acc[a][b][m][n] = (f32x4){0.f, 0.f, 0.f, 0.f};
    bf16x8 At[4][2], B0[2][2], B1[2][2];
    const char* cA = (const char*)g.A + (size_t)cur.pm * tstep; const char* cB = (const char*)g.Bt + (size_t)cur.pn * tstep;
    S.a_ready(cur);
    if constexpr (SP2) {
        PG8_STAGE(PG8_SB(0, 0), cB, voffB); PG8_STAGE(PG8_SB(0, 1), cB + hstep, voffB); PG8_STAGE(PG8_SA(0, 0), cA, voffA); PG8_STAGE(PG8_SA(0, 1), cA + hstep, voffA);
        if (wr == 1) PG8_BAR;
        PG8_WAIT_V(2); PG8_BAR;
        PG8_STAGE(PG8_SB(1, 0), cB + kstep, voffB); PG8_STAGE(PG8_SA(1, 0), cA + kstep, voffA); PG8_STAGE(PG8_SB(1, 1), cB + hstep + kstep, voffB);
        PG8_WAIT_V(6); PG8_BAR;
    } else {
        PG8_STAGE(PG8_SB(0, 0), cB, voffB); PG8_STAGE(PG8_SA(0, 0), cA, voffA); PG8_STAGE(PG8_SB(0, 1), cB + hstep, voffB); PG8_STAGE(PG8_SA(0, 1), cA + hstep, voffA);
        if (wr == 1) PG8_BAR;
        PG8_WAIT_V(4); PG8_BAR;
        PG8_STAGE(PG8_SB(1, 0), cB + kstep, voffB); PG8_STAGE(PG8_SA(1, 0), cA + kstep, voffA); PG8_STAGE(PG8_SB(1, 1), cB + hstep + kstep, voffB);
        PG8_WAIT_V(6); PG8_BAR;
    }
    for (;;) {
        const bool has_next = S.next(ui + 1, nxt);
        const char* nA = has_next ? (const char*)g.A + (size_t)nxt.pm * tstep : cA; const char* nB = has_next ? (const char*)g.Bt + (size_t)nxt.pn * tstep : cB;
        for (int t = 0; t < nt; t += 2) {
            const bool last = (t == nt - 2);
            const char* a1 = cA + (size_t)(t + 1) * kstep;
            const char* a2 = last ? nA : cA + (size_t)(t + 2) * kstep; const char* b2 = last ? nB : cB + (size_t)(t + 2) * kstep;
            const char* a3 = a2 + kstep; const char* b3 = b2 + kstep;
            if (last && has_next) S.a_ready(nxt);
            if constexpr (SP2) {
            PG8_LDB(B0, 0, 0); PG8_LDB(B1, 0, 1); PG8_SCHED; PG8_LDA(At, 0, 0); PG8_STAGE(PG8_SA(1, 1), a1 + hstep, voffA);
            PG8_WAIT_V(8); PG8_WAIT_L(0); PG8_BAR; PG8_MMA(0, 0, At, B0); PG8_MMA(0, 1, At, B1); PG8_BAR; PG8_SCHED;
            PG8_LDA(At, 0, 1); PG8_STAGE(PG8_SB(0, 0), b2, voffB); PG8_STAGE(PG8_SB(0, 1), b2 + hstep, voffB); PG8_STAGE(PG8_SA(0, 0), a2, voffA);
            PG8_WAIT_V(8); PG8_WAIT_L(0); PG8_BAR; PG8_MMA(1, 0, At, B0); PG8_MMA(1, 1, At, B1); PG8_BAR; PG8_SCHED;
            PG8_LDB(B0, 1, 0); PG8_LDB(B1, 1, 1); PG8_SCHED; PG8_LDA(At, 1, 0); PG8_STAGE(PG8_SA(0, 1), a2 + hstep, voffA);
            PG8_WAIT_V(8); PG8_WAIT_L(0); PG8_BAR; PG8_MMA(0, 0, At, B0); PG8_MMA(0, 1, At, B1); PG8_BAR; PG8_SCHED;
            PG8_LDA(At, 1, 1); PG8_STAGE(PG8_SB(1, 0), b3, voffB); PG8_STAGE(PG8_SB(1, 1), b3 + hstep, voffB); PG8_STAGE(PG8_SA(1, 0), a3, voffA);
            PG8_WAIT_V(8); PG8_WAIT_L(0); PG8_BAR; PG8_MMA(1, 0, At, B0); PG8_MMA(1, 1, At, B1); PG8_BAR; PG8_SCHED;
            } else {
            PG8_LDB(B0, 0, 0); PG8_SCHED; PG8_LDA(At, 0, 0); PG8_STAGE(PG8_SA(1, 1), a1 + hstep, voffA);
            PG8_WAIT_L(8); PG8_BAR; PG8_WAIT_L(0); PG8_MMA(0, 0, At, B0); PG8_BAR; PG8_SCHED;
            PG8_LDB(B1, 0, 1); PG8_STAGE(PG8_SB(0, 0), b2, voffB);
            PG8_BAR; PG8_WAIT_L(0); PG8_MMA(0, 1, At, B1); PG8_BAR;
            PG8_LDA(At, 0, 1); PG8_STAGE(PG8_SA(0, 0), a2, voffA);
            PG8_BAR; PG8_WAIT_L(0); PG8_MMA(1, 0, At, B0); PG8_BAR; PG8_SCHED;
            PG8_STAGE(PG8_SB(0, 1), b2 + hstep, voffB);
            PG8_WAIT_V(6); PG8_BAR; PG8_MMA(1, 1, At, B1); PG8_BAR;
            PG8_LDB(B0, 1, 0); PG8_SCHED; PG8_LDA(At, 1, 0); PG8_STAGE(PG8_SA(0, 1), a2 + hstep, voffA);
            PG8_WAIT_L(8); PG8_BAR; PG8_WAIT_L(0); PG8_MMA(0, 0, At, B0); PG8_BAR; PG8_SCHED;
            PG8_LDB(B1, 1, 1); PG8_STAGE(PG8_SB(1, 0), b3, voffB);
            PG8_BAR; PG8_WAIT_L(0); PG8_MMA(0, 1, At, B1); PG8_BAR;
            PG8_LDA(At, 1, 1); PG8_STAGE(PG8_SA(1, 0), a3, voffA);
            PG8_BAR; PG8_WAIT_L(0); PG8_MMA(1, 0, At, B0); PG8_BAR; PG8_SCHED;
            PG8_STAGE(PG8_SB(1, 1), b3 + hstep, voffB);
            PG8_WAIT_V(6); PG8_BAR; PG8_MMA(1, 1, At, B1); PG8_BAR;
            }
        }
        if constexpr (ALIGN_EPI) { if (wr == 0) PG8_BAR; }
        if constexpr (!Epi::AFTER_DRAIN) { E(acc, cur, wr, wc, fr, fq); S.done(cur); }
        if (!has_next) break;
#pragma unroll
        for (int a = 0; a < 2; ++a)
#pragma unroll
            for (int b = 0; b < 2; ++b)
#pragma unroll
                for (int m = 0; m < 4; ++m)
#pragma unroll
                    for (int n = 0; n < 2; ++n) acc[a][b][m][n] = (f32x4){0.f, 0.f, 0.f, 0.f};
        cur = nxt; cA = nA; cB = nB; ++ui;
        if constexpr (ALIGN_EPI) { if (wr == 1) PG8_BAR; }
    }
    PG8_WAIT_V(0);
    if constexpr (!ALIGN_EPI) { if (wr == 0) PG8_BAR; }
    PG8_BAR;
    if constexpr (Epi::AFTER_DRAIN) { E.fused(acc, cur, wr, wc, fr, fq, lds, wid, lane); S.done(cur); }
#undef PG8_SA
#undef PG8_SB
#undef PG8_STAGE
#undef PG8_LDA
#undef PG8_LDB
#undef PG8_MMA
#undef PG8_WAIT_V
#undef PG8_WAIT_L
#undef PG8_BAR
#undef PG8_SCHED
}
}

constexpr int D_MODEL = 1024, BATCH = 8, SEQ = 2048, DEPTH = 2, DEC_BATCH = 128, W_A = 512, W_B = 512, NGRP = 4, GD = 128, POOL_BUF = 15, CHUNK = 128, NHB = 4, HDB = 128, D_IN = 2560;
constexpr int MP = BATCH * SEQ;
constexpr int MV = MP + DEC_BATCH;
constexpr int MT = MP + 256;
constexpr int NCHUNK = MP / CHUNK;
constexpr float EPS = 1e-6f;
constexpr size_t O_YP = 0, O_YS = (size_t)MP * D_MODEL, O_PP = O_YS + (size_t)DEC_BATCH * D_MODEL, O_PS = O_PP + (size_t)DEPTH * BATCH * POOL_BUF * W_A,
                 O_CVP = O_PS + (size_t)DEPTH * DEC_BATCH * POOL_BUF * W_A, O_CVS = O_CVP + (size_t)DEPTH * BATCH * CHUNK * W_B;
constexpr size_t MiB = 1u << 20;
constexpr size_t WS_WIN = 1 * MiB, WS_WOUT = 11 * MiB, WS_WP = 15 * MiB, WS_WSB = 15 * MiB + 512 * 1024, WS_SSQ = 16 * MiB, WS_XN = 18 * MiB, WS_MIX = 51 * MiB, WS_PROJ = 84 * MiB, WS_Y1 = 166 * MiB, WS_END = 231 * MiB;
static_assert(WS_XN + (size_t)MT * D_MODEL * 2 <= WS_MIX && WS_MIX + (size_t)MT * D_MODEL * 2 <= WS_PROJ && WS_PROJ + (size_t)MT * D_IN * 2 <= WS_Y1 && WS_Y1 + (size_t)MT * D_MODEL * 4 <= WS_END && WS_SSQ + (size_t)MT * 64 <= WS_XN, "ws map");
constexpr int TS = 272;
constexpr int R_A = 0, R_B = 144 * TS, R_C = R_B + 128 * TS, R_D = R_C + 128 * TS, R_MISC = R_D + 128 * TS;
constexpr int LDS_BYTES = 152 * 1024, LDS_CTL_OFF = LDS_BYTES - 256;
constexpr size_t WS_CTL = 0, CTL_ZERO_BYTES = 16384;
static_assert(R_MISC + 4096 <= LDS_BYTES && pg8::STAGE_BYTES + 3072 <= LDS_BYTES, "LDS map");
constexpr int NWAVES = 8, NT = 512;

#define LAS __attribute__((address_space(3)))
typedef unsigned short bf16;
typedef unsigned v4u __attribute__((ext_vector_type(4)));
typedef unsigned v2u __attribute__((ext_vector_type(2)));
typedef float f32x4 __attribute__((ext_vector_type(4)));
typedef float f32x2 __attribute__((ext_vector_type(2)));
typedef short bf16x8 __attribute__((ext_vector_type(8)));
#define LDS_WAIT() asm volatile("s_waitcnt lgkmcnt(0)" ::: "memory")
__device__ __forceinline__ unsigned pk2(float lo, float hi) { return pg8::cvt_pk_bf16(lo, hi); }
__device__ __forceinline__ float bflo(unsigned w) { return __uint_as_float(w << 16); }
__device__ __forceinline__ float bfhi(unsigned w) { return __uint_as_float(w & 0xffff0000u); }
__device__ __forceinline__ float silu(float x) { return x * __builtin_amdgcn_rcpf(1.0f + __expf(-x)); }
__device__ __forceinline__ float wave_sum(float v) {
#pragma unroll
    for (int o = 1; o < 64; o <<= 1) v += __shfl_xor(v, o);
    return v;
}

#define XB_TMO      128
#define XB_XCNT(j)  (256  + 64 * (j))
#define XB_XSUB(j)  (1280 + 64 * (j))
#define XB_XGEN(j)  (2304 + 64 * (j))
#define XB_TOP      3328
#define XB_TOPGEN   3392
#define XCD_BAR_WORDS 3456
#define XB_SPIN_CAP (1u << 18)

__device__ __forceinline__ unsigned xb_ld(unsigned* p)              { return __hip_atomic_load(p, __ATOMIC_RELAXED, __HIP_MEMORY_SCOPE_AGENT); }
__device__ __forceinline__ unsigned xb_add(unsigned* p, unsigned v) { return __hip_atomic_fetch_add(p, v, __ATOMIC_RELAXED, __HIP_MEMORY_SCOPE_AGENT); }
__device__ __forceinline__ unsigned xb_xcc_id() { return (unsigned)__builtin_amdgcn_s_getreg((3 << 11) | 20) & 0xFu; }
#define XB_SPIN(cond, bar) do { unsigned _sp = 0; while (cond) { __builtin_amdgcn_s_sleep(1); \
    if ((++_sp & 255u) == 0u) { if (xb_ld(&(bar)[XB_TMO])) break; if (_sp > XB_SPIN_CAP) { atomicAdd(&(bar)[XB_TMO], 1u); break; } } } } while (0)

struct XcdBarrier {
    unsigned* bar; unsigned x;
    volatile LAS unsigned* st;
};

__device__ __forceinline__ XcdBarrier xcd_barrier_post(unsigned* bar, volatile LAS unsigned* st) {
    XcdBarrier b; b.bar = bar; b.x = xb_xcc_id(); b.st = st;
    if (threadIdx.x == 0) (void)xb_add(&bar[XB_XCNT(b.x)], 1u);
    return b;
}
__device__ __forceinline__ void xcd_barrier_complete(unsigned* bar, unsigned x, unsigned& nloc, unsigned& nx) {
    const unsigned G = gridDim.x * gridDim.y * gridDim.z;
    unsigned sum, cnt, mine, sp = 0u;
    for (;;) {
        sum = 0u; cnt = 0u; mine = 0u;
#pragma unroll
        for (unsigned j = 0; j < 16; ++j) { const unsigned c = xb_ld(&bar[XB_XCNT(j)]); sum += c; cnt += (c > 0u) ? 1u : 0u; mine = (j == x) ? c : mine; }
        if (sum == G) break;
        __builtin_amdgcn_s_sleep(1);
        if ((++sp & 255u) == 0u) { if (xb_ld(&bar[XB_TMO])) break; if (sp > XB_SPIN_CAP) { atomicAdd(&bar[XB_TMO], 1u); break; } }
    }
    nloc = mine > 0u ? mine : 1u; nx = cnt > 0u ? cnt : 1u;
}

__device__ __forceinline__ void xcd_barrier(const XcdBarrier& b) {
    asm volatile("s_waitcnt vmcnt(0)" ::: "memory");
    __syncthreads();
    if (threadIdx.x == 0) {
        unsigned* bar = b.bar;
        __builtin_amdgcn_s_waitcnt(0);
        unsigned nloc = b.st[0], nx = b.st[1];
        if (nloc == 0u) { xcd_barrier_complete(bar, b.x, nloc, nx); b.st[0] = nloc; b.st[1] = nx; }
        const unsigned old = xb_add(&bar[XB_XSUB(b.x)], 1u);
        const unsigned gen = old / nloc;
        if (old + 1u == (gen + 1u) * nloc) {
            __builtin_amdgcn_fence(__ATOMIC_RELEASE, "agent");
            asm volatile("s_waitcnt vmcnt(0)" ::: "memory");
            const unsigned og = xb_add(&bar[XB_TOP], 1u);
            const unsigned tg = og / nx;
            if (og + 1u == (tg + 1u) * nx) xb_add(&bar[XB_TOPGEN], 1u);
            else XB_SPIN(xb_ld(&bar[XB_TOPGEN]) == tg, bar);
            __builtin_amdgcn_fence(__ATOMIC_ACQUIRE, "agent");
            xb_add(&bar[XB_XGEN(b.x)], 1u);
            asm volatile("s_waitcnt vmcnt(0)" ::: "memory");
        } else {
            XB_SPIN(xb_ld(&bar[XB_XGEN(b.x)]) == gen, bar);
            __builtin_amdgcn_fence(__ATOMIC_ACQUIRE, "agent");
            asm volatile("s_waitcnt vmcnt(0)" ::: "memory");
        }
    }
    __syncthreads();
}

struct Args { const float* in[12]; float* out; unsigned char* ws; int ph_lo, ph_hi; };
struct Ctx {
    LAS unsigned char* lds; int tid, lane, wave, G, bid;
    const float *xp, *xs, *state, *norm_g, *w_in, *w_pool, *pool_scale, *vng, *w_s, *b_s, *w_out, *fng;
    float* out; bf16 *WinT, *WoutT, *WpT, *WsB, *XN, *MIX, *PROJ; float *SSQ, *Y1;
};

__device__ __forceinline__ void p0_transpose_item(const float* W, int K, int N, bf16* WT, const float* ksc, const float* nsc, LAS float* scr, int item, int lane) {
    const int nblk = N / 32, kb = item / nblk, nb = item % nblk, k0 = 64 * kb, n0 = 32 * nb;
#pragma unroll 8
    for (int i = 0; i < 32; ++i) { const int kk = 2 * i + (lane >> 5); float v = W[(size_t)(k0 + kk) * N + n0 + (lane & 31)]; if (ksc) v *= ksc[k0 + kk]; scr[kk * 33 + (lane & 31)] = v; }
    LDS_WAIT(); asm volatile("" ::: "memory");
    const int c = lane & 7;
#pragma unroll
    for (int j = 0; j < 4; ++j) { const int n = (lane >> 3) + 8 * j; const LAS float* s = scr + (8 * c) * 33 + n; const float sc = nsc ? nsc[n0 + n] : 1.0f;
        v4u o; o.x = pk2(s[0 * 33] * sc, s[1 * 33] * sc); o.y = pk2(s[2 * 33] * sc, s[3 * 33] * sc); o.z = pk2(s[4 * 33] * sc, s[5 * 33] * sc); o.w = pk2(s[6 * 33] * sc, s[7 * 33] * sc);
        *(v4u*)(WT + (size_t)(n0 + n) * K + k0 + 8 * c) = o; }
    LDS_WAIT(); asm volatile("" ::: "memory");
}
__device__ __forceinline__ void p0_prologue(Ctx& F) {
    LAS float* scr = (LAS float*)(F.lds + F.wave * 16384);
    const int gw = F.bid * NWAVES + F.wave, NGW = F.G * NWAVES;
    constexpr int I_IN = (D_MODEL / 64) * (D_IN / 32), I_OUT = (D_MODEL / 64) * (D_MODEL / 32), I_P = (GD / 64) * (GD / 32);
    constexpr int NITEMS = DEPTH * (I_IN + I_OUT + NGRP * I_P);
    for (int it = gw; it < NITEMS; it += NGW) {
        int r = it; const int l = r / (I_IN + I_OUT + NGRP * I_P); r -= l * (I_IN + I_OUT + NGRP * I_P);
        if (r < I_IN) { p0_transpose_item(F.w_in + (size_t)l * D_MODEL * D_IN, D_MODEL, D_IN, F.WinT + (size_t)l * D_IN * D_MODEL, F.norm_g + l * D_MODEL, nullptr, scr, r, F.lane); continue; } r -= I_IN;
        if (r < I_OUT) { p0_transpose_item(F.w_out + (size_t)l * D_MODEL * D_MODEL, D_MODEL, D_MODEL, F.WoutT + (size_t)l * D_MODEL * D_MODEL, nullptr, nullptr, scr, r, F.lane); continue; } r -= I_OUT;
        const int g = r / I_P; r -= g * I_P;
        p0_transpose_item(F.w_pool + (size_t)(l * NGRP + g) * GD * GD, GD, GD, F.WpT + (size_t)(l * NGRP + g) * GD * GD, nullptr, F.pool_scale + l * W_A + g * GD, scr, r, F.lane);
    }
    for (int idx = F.bid * NT + F.tid; idx < DEPTH * NHB * CHUNK * CHUNK / 2; idx += F.G * NT) { const int e = idx * 2, i = (e >> 7) & 127, j = e & 127; const f32x2 v = *(const f32x2*)(F.w_s + e);
        *(unsigned*)(F.WsB + e) = pk2(j <= i ? v.x : 0.f, (j + 1) <= i ? v.y : 0.f); }
    for (int m = gw; m < MT; m += NGW) {
        f32x4 v[4]; float s = 0.f;
        if (m < MV) { const f32x4* xr = (const f32x4*)(m < MP ? F.xp + (size_t)m * D_MODEL : F.xs + (size_t)(m - MP) * D_MODEL) + F.lane;
#pragma unroll
            for (int j = 0; j < 4; ++j) { v[j] = xr[64 * j]; s += (v[j].x * v[j].x + v[j].y * v[j].y) + (v[j].z * v[j].z + v[j].w * v[j].w); }
        } else {
#pragma unroll
            for (int j = 0; j < 4; ++j) v[j] = (f32x4){0.f, 0.f, 0.f, 0.f};
        }
        s = wave_sum(s);
        v2u* o8 = (v2u*)(F.XN + (size_t)m * D_MODEL) + F.lane;
#pragma unroll
        for (int j = 0; j < 4; ++j) { v2u w; w.x = pk2(v[j].x, v[j].y); w.y = pk2(v[j].z, v[j].w); o8[64 * j] = w; }
        if (F.lane < 16) F.SSQ[(size_t)m * 16 + F.lane] = F.lane == 0 ? s : 0.f;
    }
}

__device__ __forceinline__ void mix_head(Ctx& F, int l, int c, int h) {
    int tid_l = F.tid; asm volatile("" : "+v"(tid_l)); const int tid = tid_l, lane = tid & 63, wave = __builtin_amdgcn_readfirstlane(tid >> 6), fr = lane & 15, fq = lane >> 4; LAS unsigned char* lds = F.lds;
    const bf16* P = F.PROJ + (size_t)c * CHUNK * D_IN; const bf16* Wsb = F.WsB + (size_t)(l * NHB + h) * CHUNK * CHUNK;
    v4u ru[4], rv[4], rw[4], rg[4];
#pragma unroll
    for (int i = 0; i < 4; ++i) { const int p = tid + NT * i, row = p >> 4, ch = p & 15; const bf16* pr = P + (size_t)row * D_IN + h * HDB + ch * 8;
        ru[i] = *(const v4u*)(pr + 2 * W_A); rv[i] = *(const v4u*)(pr + 2 * W_A + W_B); rw[i] = *(const v4u*)(Wsb + row * CHUNK + ch * 8); }
#pragma unroll
    for (int i = 0; i < 4; ++i) { const int p = tid + NT * i, row = p >> 4, ch = p & 15, o = row * TS + ch * 16;
        *(LAS v4u*)(lds + R_A + o) = ru[i]; *(LAS v4u*)(lds + R_B + o) = rv[i]; *(LAS v4u*)(lds + R_D + o) = rw[i]; }
    __syncthreads();
#pragma unroll
    for (int i = 0; i < 4; ++i) { const int p = tid + NT * i, row = p >> 4, ch = p & 15; rg[i] = *(const v4u*)(P + (size_t)row * D_IN + 2 * W_A + 2 * W_B + h * HDB + ch * 8); }
    const int j = tid & 127, q = tid >> 7;
    float x[32]; float ss = 0.f;
#pragma unroll
    for (int i = 0; i < 4; ++i) { const v4u w = *(const LAS v4u*)(lds + R_B + j * TS + (4 * q + i) * 16);
        x[8 * i + 0] = bflo(w.x); x[8 * i + 1] = bfhi(w.x); x[8 * i + 2] = bflo(w.y); x[8 * i + 3] = bfhi(w.y); x[8 * i + 4] = bflo(w.z); x[8 * i + 5] = bfhi(w.z); x[8 * i + 6] = bflo(w.w); x[8 * i + 7] = bfhi(w.w); }
#pragma unroll
    for (int e = 0; e < 32; ++e) ss += x[e] * x[e];
    LAS float* part = (LAS float*)(lds + R_MISC);
    part[q * 128 + j] = ss;
    __syncthreads();
    ss = (part[j] + part[128 + j]) + (part[256 + j] + part[384 + j]);
    const float rstd = __builtin_amdgcn_rsqf(ss * (1.0f / HDB) + EPS);
    const float* gp = F.vng + l * W_B + h * HDB + q * 32;
    const bool wcv = (c & 15) == 15;
    float* cvp = F.out + O_CVP + ((size_t)(l * BATCH + (c >> 4)) * CHUNK + j) * W_B + h * HDB + q * 32;
#pragma unroll
    for (int i = 0; i < 8; ++i) { const f32x4 g4 = *(const f32x4*)(gp + 4 * i); f32x4 o;
        o.x = x[4 * i] * rstd * g4.x; o.y = x[4 * i + 1] * rstd * g4.y; o.z = x[4 * i + 2] * rstd * g4.z; o.w = x[4 * i + 3] * rstd * g4.w;
        x[4 * i] = o.x; x[4 * i + 1] = o.y; x[4 * i + 2] = o.z; x[4 * i + 3] = o.w;
        if (wcv) *(f32x4*)(cvp + 4 * i) = o; }
#pragma unroll
    for (int e = 0; e < 32; e += 2) { const unsigned w = pk2(x[e], x[e + 1]);
        *(LAS unsigned short*)(lds + R_C + (q * 32 + e) * TS + j * 2) = (unsigned short)(w & 0xffffu);
        *(LAS unsigned short*)(lds + R_C + (q * 32 + e + 1) * TS + j * 2) = (unsigned short)(w >> 16); }
    __syncthreads();
#pragma unroll
    for (int i = 0; i < 4; ++i) { const int p = tid + NT * i, row = p >> 4, ch = p & 15; *(LAS v4u*)(lds + R_B + row * TS + ch * 16) = rg[i]; }
    const int ib0 = (wave >> 1) * 2, db0 = (wave & 1) * 4;
    f32x4 acc[2][4];
#pragma unroll
    for (int a = 0; a < 2; ++a)
#pragma unroll
        for (int b = 0; b < 4; ++b) acc[a][b] = (f32x4){0.f, 0.f, 0.f, 0.f};
#pragma unroll
    for (int ks = 0; ks < 4; ++ks) { bf16x8 af[4], bfr[2];
#pragma unroll
        for (int b = 0; b < 4; ++b) af[b] = *(const LAS bf16x8*)(lds + R_C + (16 * (db0 + b) + fr) * TS + (32 * ks + 8 * fq) * 2);
#pragma unroll
        for (int a = 0; a < 2; ++a) bfr[a] = *(const LAS bf16x8*)(lds + R_D + (16 * (ib0 + a) + fr) * TS + (32 * ks + 8 * fq) * 2);
#pragma unroll
        for (int a = 0; a < 2; ++a)
#pragma unroll
            for (int b = 0; b < 4; ++b) acc[a][b] = __builtin_amdgcn_mfma_f32_16x16x32_bf16(af[b], bfr[a], acc[a][b], 0, 0, 0); }
    __syncthreads();
    const float* bsp = F.b_s + (l * NHB + h) * CHUNK;
#pragma unroll
    for (int a = 0; a < 2; ++a) { const int i = 16 * (ib0 + a) + fr; const float bsv = bsp[i];
#pragma unroll
        for (int b = 0; b < 4; ++b) { const int d = 16 * (db0 + b) + 4 * fq; const int o = i * TS + d * 2;
            const v2u uu = *(const LAS v2u*)(lds + R_A + o), gg = *(const LAS v2u*)(lds + R_B + o);
            const float o0 = bflo(uu.x) * (acc[a][b][0] + bsv) * silu(bflo(gg.x)), o1 = bfhi(uu.x) * (acc[a][b][1] + bsv) * silu(bfhi(gg.x));
            const float o2 = bflo(uu.y) * (acc[a][b][2] + bsv) * silu(bflo(gg.y)), o3 = bfhi(uu.y) * (acc[a][b][3] + bsv) * silu(bfhi(gg.y));
            v2u w; w.x = pk2(o0, o1); w.y = pk2(o2, o3); *(LAS v2u*)(lds + R_A + o) = w; } }
    __syncthreads();
    bf16* Mx = F.MIX + (size_t)c * CHUNK * D_MODEL + W_A + h * HDB;
#pragma unroll
    for (int i = 0; i < 4; ++i) { const int p = tid + NT * i, row = p >> 4, ch = p & 15; *(v4u*)(Mx + (size_t)row * D_MODEL + ch * 8) = *(const LAS v4u*)(lds + R_A + row * TS + ch * 16); }
    __syncthreads();
}
__device__ __forceinline__ void mix_pool(Ctx& F, int l, int c, int g) {
    int tid_l = F.tid; asm volatile("" : "+v"(tid_l)); const int tid = tid_l, lane = tid & 63, wave = __builtin_amdgcn_readfirstlane(tid >> 6), fr = lane & 15, fq = lane >> 4; LAS unsigned char* lds = F.lds;
    const bool first = (c & 15) == 0; const int w = 2 << g;
    const bf16* P = F.PROJ + (size_t)c * CHUNK * D_IN + g * GD; const bf16* Wp = F.WpT + (size_t)(l * NGRP + g) * GD * GD;
    v4u ra[4], rg[4], rw[4], rh = (v4u){0u, 0u, 0u, 0u};
#pragma unroll
    for (int i = 0; i < 4; ++i) { const int p = tid + NT * i, row = p >> 4, ch = p & 15; const bf16* pr = P + (size_t)row * D_IN + ch * 8;
        ra[i] = *(const v4u*)pr; rg[i] = *(const v4u*)(pr + W_A); rw[i] = *(const v4u*)(Wp + row * GD + ch * 8); }
    if (tid < 256 && !first) rh = *(const v4u*)(P - (size_t)16 * D_IN + (size_t)(tid >> 4) * D_IN + (tid & 15) * 8);
#pragma unroll
    for (int i = 0; i < 4; ++i) { const int p = tid + NT * i, row = p >> 4, ch = p & 15, o = row * TS + ch * 16;
        *(LAS v4u*)(lds + R_A + 16 * TS + o) = ra[i]; *(LAS v4u*)(lds + R_B + o) = rg[i]; *(LAS v4u*)(lds + R_D + o) = rw[i]; }
    if (tid < 256) *(LAS v4u*)(lds + R_A + (tid >> 4) * TS + (tid & 15) * 16) = rh;
    __syncthreads();
    {
        const int cg4 = tid & 31, t0 = (tid >> 5) * 8; const LAS unsigned char* ap = lds + R_A + 16 * TS + cg4 * 8;
        f32x4 S = (f32x4){0.f, 0.f, 0.f, 0.f};
        for (int k = 0; k < w; ++k) { const v2u a = *(const LAS v2u*)(ap + (t0 - k) * TS); S.x += bflo(a.x); S.y += bfhi(a.x); S.z += bflo(a.y); S.w += bfhi(a.y); }
#pragma unroll
        for (int tt = 0; tt < 8; ++tt) { const int t = t0 + tt; const v2u a = *(const LAS v2u*)(ap + t * TS);
            const int cnt = first ? ((t + 1) < w ? (t + 1) : w) : w; const float ic = 1.0f / (float)cnt;
            v2u o; o.x = pk2(S.x * ic - bflo(a.x), S.y * ic - bfhi(a.x)); o.y = pk2(S.z * ic - bflo(a.y), S.w * ic - bfhi(a.y));
            *(LAS v2u*)(lds + R_C + t * TS + cg4 * 8) = o;
            if (tt < 7) { const v2u n = *(const LAS v2u*)(ap + (t + 1) * TS), d = *(const LAS v2u*)(ap + (t + 1 - w) * TS);
                S.x += bflo(n.x) - bflo(d.x); S.y += bfhi(n.x) - bfhi(d.x); S.z += bflo(n.y) - bflo(d.y); S.w += bfhi(n.y) - bfhi(d.y); } }
        if ((c & 15) == 15 && tid < POOL_BUF * 32) { const int r = tid >> 5; const v2u a = *(const LAS v2u*)(ap + (CHUNK - POOL_BUF + r) * TS);
            *(f32x4*)(F.out + O_PP + ((size_t)(l * BATCH + (c >> 4)) * POOL_BUF + r) * W_A + g * GD + cg4 * 4) = (f32x4){bflo(a.x), bfhi(a.x), bflo(a.y), bfhi(a.y)}; }
    }
    __syncthreads();
    const int tb0 = (wave >> 1) * 2, db0 = (wave & 1) * 4;
    f32x4 acc[2][4];
#pragma unroll
    for (int a = 0; a < 2; ++a)
#pragma unroll
        for (int b = 0; b < 4; ++b) acc[a][b] = (f32x4){0.f, 0.f, 0.f, 0.f};
#pragma unroll
    for (int ks = 0; ks < 4; ++ks) { bf16x8 af[4], bfr[2];
#pragma unroll
        for (int b = 0; b < 4; ++b) af[b] = *(const LAS bf16x8*)(lds + R_D + (16 * (db0 + b) + fr) * TS + (32 * ks + 8 * fq) * 2);
#pragma unroll
        for (int a = 0; a < 2; ++a) bfr[a] = *(const LAS bf16x8*)(lds + R_C + (16 * (tb0 + a) + fr) * TS + (32 * ks + 8 * fq) * 2);
#pragma unroll
        for (int a = 0; a < 2; ++a)
#pragma unroll
            for (int b = 0; b < 4; ++b) acc[a][b] = __builtin_amdgcn_mfma_f32_16x16x32_bf16(af[b], bfr[a], acc[a][b], 0, 0, 0); }
#pragma unroll
    for (int a = 0; a < 2; ++a) { const int t = 16 * (tb0 + a) + fr;
#pragma unroll
        for (int b = 0; b < 4; ++b) { const int d = 16 * (db0 + b) + 4 * fq; const int o = t * TS + d * 2;
            const v2u gg = *(const LAS v2u*)(lds + R_B + o);
            v2u wv; wv.x = pk2(acc[a][b][0] * silu(bflo(gg.x)), acc[a][b][1] * silu(bfhi(gg.x))); wv.y = pk2(acc[a][b][2] * silu(bflo(gg.y)), acc[a][b][3] * silu(bfhi(gg.y)));
            *(LAS v2u*)(lds + R_B + o) = wv; } }
    __syncthreads();
    bf16* Mx = F.MIX + (size_t)c * CHUNK * D_MODEL + g * GD;
#pragma unroll
    for (int i = 0; i < 4; ++i) { const int p = tid + NT * i, row = p >> 4, ch = p & 15; *(v4u*)(Mx + (size_t)row * D_MODEL + ch * 8) = *(const LAS v4u*)(lds + R_B + row * TS + ch * 16); }
    __syncthreads();
}
__device__ __forceinline__ void mix_pool_sample(Ctx& F, int l, int g, int sb) {
    int tid_l = F.tid; asm volatile("" : "+v"(tid_l)); const int tid = tid_l, lane = tid & 63, wave = __builtin_amdgcn_readfirstlane(tid >> 6), fr = lane & 15, fq = lane >> 4; LAS unsigned char* lds = F.lds;
    const int w = 2 << g; const int sl = tid >> 5, c4 = tid & 31, s = sb * 16 + sl;
    const bf16* Wp = F.WpT + (size_t)(l * NGRP + g) * GD * GD;
    v4u rw[4];
#pragma unroll
    for (int i = 0; i < 4; ++i) { const int p = tid + NT * i, row = p >> 4, ch = p & 15; rw[i] = *(const v4u*)(Wp + row * GD + ch * 8); }
    const bf16* pr = F.PROJ + (size_t)(MP + s) * D_IN + g * GD;
    const v2u a = *(const v2u*)(pr + c4 * 4);
    v4u rgate = (v4u){0u, 0u, 0u, 0u};
    if (tid < 256) rgate = *(const v4u*)(F.PROJ + (size_t)(MP + sb * 16 + (tid >> 4)) * D_IN + W_A + g * GD + (tid & 15) * 8);
    const f32x4 av = (f32x4){bflo(a.x), bfhi(a.x), bflo(a.y), bfhi(a.y)};
    const float* sp = F.state + ((size_t)(l * DEC_BATCH + s) * POOL_BUF) * W_A + g * GD + c4 * 4;
    float* op = F.out + O_PS + ((size_t)(l * DEC_BATCH + s) * POOL_BUF) * W_A + g * GD + c4 * 4;
    f32x4 S = av;
#pragma unroll
    for (int r = 0; r < POOL_BUF; ++r) { const f32x4 v = *(const f32x4*)(sp + (size_t)r * W_A);
        if (r >= 16 - w) S += v;
        if (r >= 1) *(f32x4*)(op + (size_t)(r - 1) * W_A) = v; }
    *(f32x4*)(op + (size_t)(POOL_BUF - 1) * W_A) = av;
    const float ic = 1.0f / (float)w;
    { v2u o; o.x = pk2(S.x * ic - av.x, S.y * ic - av.y); o.y = pk2(S.z * ic - av.z, S.w * ic - av.w); *(LAS v2u*)(lds + R_C + sl * TS + c4 * 8) = o; }
#pragma unroll
    for (int i = 0; i < 4; ++i) { const int p = tid + NT * i, row = p >> 4, ch = p & 15; *(LAS v4u*)(lds + R_D + row * TS + ch * 16) = rw[i]; }
    if (tid < 256) *(LAS v4u*)(lds + R_B + (tid >> 4) * TS + (tid & 15) * 16) = rgate;
    __syncthreads();
    f32x4 acc = (f32x4){0.f, 0.f, 0.f, 0.f};
#pragma unroll
    for (int ks = 0; ks < 4; ++ks) { const bf16x8 af = *(const LAS bf16x8*)(lds + R_D + (16 * wave + fr) * TS + (32 * ks + 8 * fq) * 2), bfr = *(const LAS bf16x8*)(lds + R_C + fr * TS + (32 * ks + 8 * fq) * 2);
        acc = __builtin_amdgcn_mfma_f32_16x16x32_bf16(af, bfr, acc, 0, 0, 0); }
    { const int o = fr * TS + (16 * wave + 4 * fq) * 2; const v2u gg = *(const LAS v2u*)(lds + R_B + o);
      v2u wv; wv.x = pk2(acc[0] * silu(bflo(gg.x)), acc[1] * silu(bfhi(gg.x))); wv.y = pk2(acc[2] * silu(bflo(gg.y)), acc[3] * silu(bfhi(gg.y)));
      *(LAS v2u*)(lds + R_B + o) = wv; }
    __syncthreads();
    if (tid < 256) *(v4u*)(F.MIX + (size_t)(MP + sb * 16 + (tid >> 4)) * D_MODEL + g * GD + (tid & 15) * 8) = *(const LAS v4u*)(lds + R_B + (tid >> 4) * TS + (tid & 15) * 16);
    __syncthreads();
}
__device__ __forceinline__ void mix_head_sample(Ctx& F, int l, int h) {
    int tid_l = F.tid; asm volatile("" : "+v"(tid_l)); const int tid = tid_l, s = tid >> 2, q = tid & 3;
    const bf16* pr = F.PROJ + (size_t)(MP + s) * D_IN + 2 * W_A + h * HDB + q * 32;
    v4u ru[4], rv[4], rg[4];
#pragma unroll
    for (int i = 0; i < 4; ++i) { ru[i] = *(const v4u*)(pr + 8 * i); rv[i] = *(const v4u*)(pr + W_B + 8 * i); rg[i] = *(const v4u*)(pr + 2 * W_B + 8 * i); }
    float ss = 0.f;
#pragma unroll
    for (int i = 0; i < 4; ++i) { const v4u w = rv[i]; float t;
        t = bflo(w.x); ss += t * t; t = bfhi(w.x); ss += t * t; t = bflo(w.y); ss += t * t; t = bfhi(w.y); ss += t * t; t = bflo(w.z); ss += t * t; t = bfhi(w.z); ss += t * t; t = bflo(w.w); ss += t * t; t = bfhi(w.w); ss += t * t; }
    ss += __shfl_xor(ss, 1); ss += __shfl_xor(ss, 2);
    const float rstd = __builtin_amdgcn_rsqf(ss * (1.0f / HDB) + EPS);
    const float w00 = F.w_s[(size_t)(l * NHB + h) * CHUNK * CHUNK], b0 = F.b_s[(l * NHB + h) * CHUNK];
    const float* gp = F.vng + l * W_B + h * HDB + q * 32;
    float* cvp = F.out + O_CVS + (size_t)(l * DEC_BATCH + s) * W_B + h * HDB + q * 32;
    bf16* mx = F.MIX + (size_t)(MP + s) * D_MODEL + W_A + h * HDB + q * 32;
#pragma unroll
    for (int i = 0; i < 4; ++i) { const v4u wu = ru[i], wv = rv[i], wg = rg[i]; const f32x4 g0 = *(const f32x4*)(gp + 8 * i), g1 = *(const f32x4*)(gp + 8 * i + 4);
        f32x4 n0, n1; n0.x = bflo(wv.x) * rstd * g0.x; n0.y = bfhi(wv.x) * rstd * g0.y; n0.z = bflo(wv.y) * rstd * g0.z; n0.w = bfhi(wv.y) * rstd * g0.w;
        n1.x = bflo(wv.z) * rstd * g1.x; n1.y = bfhi(wv.z) * rstd * g1.y; n1.z = bflo(wv.w) * rstd * g1.z; n1.w = bfhi(wv.w) * rstd * g1.w;
        *(f32x4*)(cvp + 8 * i) = n0; *(f32x4*)(cvp + 8 * i + 4) = n1;
        v4u o;
        o.x = pk2(bflo(wu.x) * (w00 * n0.x + b0) * silu(bflo(wg.x)), bfhi(wu.x) * (w00 * n0.y + b0) * silu(bfhi(wg.x)));
        o.y = pk2(bflo(wu.y) * (w00 * n0.z + b0) * silu(bflo(wg.y)), bfhi(wu.y) * (w00 * n0.w + b0) * silu(bfhi(wg.y)));
        o.z = pk2(bflo(wu.z) * (w00 * n1.x + b0) * silu(bflo(wg.z)), bfhi(wu.z) * (w00 * n1.y + b0) * silu(bfhi(wg.z)));
        o.w = pk2(bflo(wu.w) * (w00 * n1.z + b0) * silu(bflo(wg.w)), bfhi(wu.w) * (w00 * n1.w + b0) * silu(bfhi(wg.w)));
        *(v4u*)(mx + 8 * i) = o; }
}
constexpr int NU_PROMPT = NCHUNK * 8, NU_SPOOL = NGRP * 8, NU_SHEAD = NHB, NU_MIX = NU_PROMPT + NU_SPOOL + NU_SHEAD;
__device__ __forceinline__ void p2_mixers(Ctx& F, int l) {
    for (int u = F.bid; u < NU_MIX; u += F.G) {
        if (u < NU_PROMPT) { const int c = u >> 3, p = u & 7; if (p < 4) mix_pool(F, l, c, p); else mix_head(F, l, c, p - 4); }
        else if (u < NU_PROMPT + NU_SPOOL) { const int r = u - NU_PROMPT; mix_pool_sample(F, l, r >> 3, r & 7); }
        else mix_head_sample(F, l, u - NU_PROMPT - NU_SPOOL);
    }
}
__device__ __forceinline__ void p3_sample_out(Ctx& F, int l) {
    if (F.bid >= 128) return;
    int tid_l = F.tid; asm volatile("" : "+v"(tid_l)); const int tid = tid_l, lane = tid & 63, wave = __builtin_amdgcn_readfirstlane(tid >> 6), fr = lane & 15, fq = lane >> 4; LAS unsigned char* lds = F.lds;
    const int tr = F.bid >> 4, tc = F.bid & 15; const bool last = l == DEPTH - 1;
    const bf16* A = F.MIX + (size_t)(MP + 16 * tr + fr) * D_MODEL + 128 * wave + 8 * fq;
    const bf16* B = F.WoutT + (size_t)l * D_MODEL * D_MODEL + (size_t)(64 * tc + fr) * D_MODEL + 128 * wave + 8 * fq;
    f32x4 acc[4];
#pragma unroll
    for (int nb = 0; nb < 4; ++nb) acc[nb] = (f32x4){0.f, 0.f, 0.f, 0.f};
#pragma unroll
    for (int ks = 0; ks < 4; ++ks) { const bf16x8 af = *(const bf16x8*)(A + 32 * ks);
#pragma unroll
        for (int nb = 0; nb < 4; ++nb) { const bf16x8 bfr = *(const bf16x8*)(B + (size_t)(16 * nb) * D_MODEL + 32 * ks); acc[nb] = __builtin_amdgcn_mfma_f32_16x16x32_bf16(bfr, af, acc[nb], 0, 0, 0); } }
#pragma unroll
    for (int nb = 0; nb < 4; ++nb) *(LAS f32x4*)(lds + ((wave * 16 + fr) * 64 + 16 * nb + 4 * fq) * 4) = acc[nb];
    __syncthreads();
    const int s = tid >> 5, n2 = (tid & 31) * 2; f32x2 sum = (f32x2){0.f, 0.f};
#pragma unroll
    for (int wv = 0; wv < 8; ++wv) sum += *(const LAS f32x2*)(lds + ((wv * 16 + s) * 64 + n2) * 4);
    const int row = MP + 16 * tr + s, col = 64 * tc + n2;
    const unsigned bw = *(const unsigned*)(F.XN + (size_t)row * D_MODEL + col);
    const f32x2 o = (f32x2){bflo(bw), bfhi(bw)} + sum;
    if (last) *(f32x2*)(F.out + (size_t)row * D_MODEL + col) = o;
    else { *(unsigned*)(F.XN + (size_t)row * D_MODEL + col) = pk2(o.x, o.y);
        float q = o.x * o.x + o.y * o.y;
#pragma unroll
        for (int of = 1; of < 32; of <<= 1) q += __shfl_xor(q, of);
        if ((tid & 31) == 0) F.SSQ[(size_t)row * 16 + tc] = q; }
    __syncthreads();
}
__device__ __forceinline__ void p4_final(Ctx& F) {
    const int gw = F.bid * NWAVES + F.wave, NGW = F.G * NWAVES;
    f32x4 g[4];
#pragma unroll
    for (int j = 0; j < 4; ++j) g[j] = ((const f32x4*)F.fng)[F.lane + 64 * j];
    for (int m = gw; m < MV; m += NGW) { f32x4* xr = (f32x4*)(F.out + (size_t)m * D_MODEL) + F.lane; f32x4 v[4]; float s = 0.f;
#pragma unroll
        for (int j = 0; j < 4; ++j) { v[j] = xr[64 * j]; s += (v[j].x * v[j].x + v[j].y * v[j].y) + (v[j].z * v[j].z + v[j].w * v[j].w); }
        const float rstd = __builtin_amdgcn_rsqf(wave_sum(s) * (1.0f / D_MODEL) + EPS);
#pragma unroll
        for (int j = 0; j < 4; ++j) xr[64 * j] = v[j] * rstd * g[j]; }
}

#ifndef MK_REPEAT_MASK
#define MK_REPEAT_MASK 0
#endif
#ifndef MK_COOP
#define MK_COOP 1
#endif
constexpr int N_PHASES = 8;
__global__ void __launch_bounds__(NT, 2) fwd_megakernel(Args args) {
    extern __shared__ __attribute__((aligned(16))) unsigned char lds_raw[];
    Ctx F;
    F.lds = (LAS unsigned char*)lds_raw; F.tid = threadIdx.x; F.lane = F.tid & 63; F.wave = __builtin_amdgcn_readfirstlane(F.tid >> 6); F.G = gridDim.x; F.bid = blockIdx.x;
    F.xp = args.in[0]; F.xs = args.in[1]; F.state = args.in[2]; F.norm_g = args.in[3]; F.w_in = args.in[4]; F.w_pool = args.in[5]; F.pool_scale = args.in[6]; F.vng = args.in[7];
    F.w_s = args.in[8]; F.b_s = args.in[9]; F.w_out = args.in[10]; F.fng = args.in[11]; F.out = args.out;
    unsigned char* ws = args.ws;
    F.WinT = (bf16*)(ws + WS_WIN); F.WoutT = (bf16*)(ws + WS_WOUT); F.WpT = (bf16*)(ws + WS_WP); F.WsB = (bf16*)(ws + WS_WSB); F.SSQ = (float*)(ws + WS_SSQ);
    F.XN = (bf16*)(ws + WS_XN); F.MIX = (bf16*)(ws + WS_MIX); F.PROJ = (bf16*)(ws + WS_PROJ); F.Y1 = (float*)(ws + WS_Y1);
    const int lo = args.ph_lo, hi = args.ph_hi;
#if MK_COOP
    volatile LAS unsigned* misc = (volatile LAS unsigned*)(F.lds + LDS_CTL_OFF);
    if (F.tid < 64) misc[F.tid] = 0u;
    __syncthreads();
    XcdBarrier bar = xcd_barrier_post((unsigned*)(ws + WS_CTL), misc + 8);
    if (hi > 1000) cg::this_grid().sync();
#define SEAM(k) do { if (lo <= (k) && (k) + 1 < hi) xcd_barrier(bar); } while (0)
#else
#define SEAM(k) do { } while (0)
#endif
#define IN(k) (lo <= (k) && (k) < hi)
    if (IN(0)) { p0_prologue(F); SEAM(0); }
    for (int l = 0; l < DEPTH; ++l) {
        if (IN(1 + 3 * l)) {
            pg8::Gemm g{F.XN, F.WinT + (size_t)l * D_IN * D_MODEL, MT, D_IN, D_MODEL}; pg8::StaticOrder S; S.init(MT, D_IN, F.G, F.bid);
            LAS float* rs = (LAS float*)(F.lds + pg8::STAGE_BYTES); int pmv[3] = {-1, -1, -1};
#pragma unroll
            for (int i = 0; i < 3; ++i) { pg8::Unit u; if (S.next(i, u)) { pmv[i] = u.pm; const int r = F.tid >> 1, hf = F.tid & 1; const f32x4* sp = (const f32x4*)(F.SSQ + (size_t)(u.pm * 256 + r) * 16 + hf * 8);
                const f32x4 s0 = sp[0], s1 = sp[1]; float s = ((s0[0] + s0[1]) + (s0[2] + s0[3])) + ((s1[0] + s1[1]) + (s1[2] + s1[3])); s += __shfl_xor(s, 1);
                if (hf == 0) rs[i * 256 + r] = __builtin_amdgcn_rsqf(s * (1.0f / D_MODEL) + EPS); } }
            __syncthreads();
            pg8::EpiProj E{F.PROJ, D_IN, rs, pmv[0], pmv[1]};
            pg8::gemm_phase<pg8::EpiProj, pg8::StaticOrder, true, true>(F.lds, g, S, E);
            SEAM(1 + 3 * l);
        }
        if (IN(2 + 3 * l)) { p2_mixers(F, l); SEAM(2 + 3 * l); }
        if (IN(3 + 3 * l)) {
            pg8::Gemm g{F.MIX, F.WoutT + (size_t)l * D_MODEL * D_MODEL, MP, D_MODEL, D_MODEL}; pg8::StaticOrder S; S.init(MP, D_MODEL, F.G, F.bid);
            pg8::EpiOut E{F.out, F.XN, F.SSQ, D_MODEL, l == DEPTH - 1 ? 1 : 0};
            pg8::gemm_phase<pg8::EpiOut, pg8::StaticOrder, true, true>(F.lds, g, S, E);
            p3_sample_out(F, l);
            SEAM(3 + 3 * l);
        }
    }
    if (IN(7)) p4_final(F);
}

extern "C" void kernel_launch(void* const* d_in, const int* in_sizes, int n_in, void* d_out, int out_size, void* d_ws, size_t ws_size, hipStream_t stream) {
    static int grid = 0;
    if (grid == 0) {
        if (n_in != 12 || ws_size < WS_END) { fprintf(stderr, "kernel_launch: unexpected inputs (n_in %d, ws %zu)\n", n_in, ws_size); grid = -1; return; }
        int dev = 0, cus = 0, per_cu = 0;
        if (hipGetDevice(&dev) != hipSuccess || hipDeviceGetAttribute(&cus, hipDeviceAttributeMultiprocessorCount, dev) != hipSuccess) { grid = -1; return; }
        if (hipFuncSetAttribute((const void*)fwd_megakernel, hipFuncAttributeMaxDynamicSharedMemorySize, LDS_BYTES) != hipSuccess) { fprintf(stderr, "kernel_launch: hipFuncSetAttribute failed\n"); grid = -1; return; }
        if (hipOccupancyMaxActiveBlocksPerMultiprocessor(&per_cu, (const void*)fwd_megakernel, NT, LDS_BYTES) != hipSuccess || per_cu < 1) { fprintf(stderr, "kernel_launch: occupancy query says %d\n", per_cu); per_cu = 1; }
        (void)hipGetLastError();
        grid = cus;
    }
    if (grid < 0) return;
    Args a{};
#if MK_COOP
    if (hipMemsetAsync((char*)d_ws + WS_CTL, 0, CTL_ZERO_BYTES, stream) != hipSuccess) { fprintf(stderr, "kernel_launch: hipMemsetAsync failed\n"); return; }
#endif
    for (int i = 0; i < 12; ++i) a.in[i] = (const float*)d_in[i];
    a.out = (float*)d_out; a.ws = (unsigned char*)d_ws;
#if MK_COOP
    a.ph_lo = 0; a.ph_hi = N_PHASES;
    void* kargs[] = {&a};
    hipError_t e = hipLaunchCooperativeKernel((const void*)fwd_megakernel, dim3(grid), dim3(NT), kargs, LDS_BYTES, stream);
    if (e != hipSuccess) fprintf(stderr, "kernel_launch: cooperative launch failed: %s (grid %d)\n", hipGetErrorString(e), grid);
#else
    for (int p = 0; p < N_PHASES; ++p) { a.ph_lo = p; a.ph_hi = p + 1; const int reps = ((MK_REPEAT_MASK >> p) & 1) ? 2 : 1;
        for (int r = 0; r < reps; ++r) hipLaunchKernelGGL(fwd_megakernel, dim3(grid), dim3(NT), LDS_BYTES, stream, a); }
#endif
}
```
